# Optimizing an MI355X kernel written in HIP

```python
import math
import jax, jax.numpy as jnp
from jax import lax
import numpy as np

D_MODEL = 4096
BATCH = 4
SEQ = 4096
DEPTH = 4

CHUNK = 64
N_MIXERS = 2
CONV_WIDTH = 3
D_FF = 11008
N_HEADS = 32
Q_LORA_RANK = 1024
KV_LORA_RANK = 512
QK_NOPE_DIM = 128
QK_ROPE_DIM = 64
QK_HEAD_DIM = QK_NOPE_DIM + QK_ROPE_DIM
V_HEAD_DIM = 128
Q_BLOCK = 128
ROPE_BASE = 10000.0
NORM_EPS = 1e-6
ATTN_SCALE = QK_HEAD_DIM ** -0.5

kernel_name = "hybrid_shortconv_mla_convffn_trunk"


def rms_norm(x, g):
    xf = x.astype(jnp.float32)
    y = xf * lax.rsqrt(jnp.mean(xf * xf, axis=-1, keepdims=True) + NORM_EPS)
    return (y * g.astype(jnp.float32)).astype(x.dtype)


def causal_dwconv(x, w):
    s = x.shape[1]
    xp = jnp.pad(x, ((0, 0), (CONV_WIDTH - 1, 0), (0, 0)))
    y = w[0] * xp[:, 0:s]
    for k in range(1, CONV_WIDTH):
        y = y + w[k] * xp[:, k:k + s]
    return y


def rope_cos_sin(positions):
    inv_freq = ROPE_BASE ** (-jnp.arange(0, QK_ROPE_DIM, 2, dtype=jnp.float32) / QK_ROPE_DIM)
    ang = positions.astype(jnp.float32)[..., None] * inv_freq
    return jnp.cos(ang), jnp.sin(ang)


def apply_rope(x, cos, sin):
    half = x.shape[-1] // 2
    x1 = x[..., :half].astype(jnp.float32)
    x2 = x[..., half:].astype(jnp.float32)
    out = jnp.concatenate([x1 * cos - x2 * sin, x1 * sin + x2 * cos], axis=-1)
    return out.astype(x.dtype)


def short_conv_mixer(h, w_in, conv_w, w_out):
    bcv = h @ w_in
    b, c, v = jnp.split(bcv, 3, axis=-1)
    y = b * causal_dwconv(c * v, conv_w)
    return y @ w_out


def mla_mixer(h, cos, sin, wq_a, q_norm_g, wq_b, wkv_a, kv_norm_g, wkv_b, wo):
    bsz, s, _ = h.shape
    q = (rms_norm(h @ wq_a, q_norm_g) @ wq_b).reshape(bsz, s, N_HEADS, QK_HEAD_DIM)
    q_nope = q[..., :QK_NOPE_DIM]
    q_rope = apply_rope(q[..., QK_NOPE_DIM:], cos[:, :, None], sin[:, :, None])
    kv = h @ wkv_a
    c_kv = rms_norm(kv[..., :KV_LORA_RANK], kv_norm_g)
    k_rope = apply_rope(kv[..., KV_LORA_RANK:], cos, sin)
    wkv_b_r = wkv_b.reshape(KV_LORA_RANK, N_HEADS, QK_NOPE_DIM + V_HEAD_DIM)
    w_uk = wkv_b_r[..., :QK_NOPE_DIM]
    w_uv = wkv_b_r[..., QK_NOPE_DIM:]
    n_blocks = s // Q_BLOCK
    key_chunk = jnp.arange(s) // CHUNK

    def to_blocks(t):
        return jnp.moveaxis(t.reshape(bsz, n_blocks, Q_BLOCK, *t.shape[2:]), 1, 0)

    def attend(args):
        qn, qr, blk = args
        q_lat = jnp.einsum('bqhd,chd->bqhc', qn, w_uk)
        scores = (jnp.einsum('bqhc,bkc->bhqk', q_lat, c_kv, preferred_element_type=jnp.float32)
                  + jnp.einsum('bqhr,bkr->bhqk', qr, k_rope, preferred_element_type=jnp.float32)) * ATTN_SCALE
        q_chunk = (blk * Q_BLOCK + jnp.arange(Q_BLOCK)) // CHUNK
        mask = key_chunk[None, :] <= q_chunk[:, None]
        scores = jnp.where(mask[None, None], scores, -jnp.inf)
        p = jax.nn.softmax(scores, axis=-1).astype(c_kv.dtype)
        o_lat = jnp.einsum('bhqk,bkc->bqhc', p, c_kv)
        return jnp.einsum('bqhc,chd->bqhd', o_lat, w_uv)

    o = lax.map(attend, (to_blocks(q_nope), to_blocks(q_rope), jnp.arange(n_blocks)))
    o = jnp.moveaxis(o, 0, 1).reshape(bsz, s, N_HEADS * V_HEAD_DIM)
    return o @ wo


def conv_ffn(h, w_gate, w_up, conv_w, conv_b, w_down):
    g = causal_dwconv(h @ w_gate, conv_w) + conv_b
    return (jax.nn.silu(g) * (h @ w_up)) @ w_down


def setup_inputs(seed: int = 0) -> dict:
    key = jax.random.key(seed)
    ks = jax.random.split(key, 24)
    n_conv = (DEPTH + N_MIXERS - 1) // N_MIXERS
    n_mla = DEPTH // N_MIXERS
    f32 = jnp.float32

    def w(k, shape, fan_in):
        return jax.random.normal(k, shape, f32) * (fan_in ** -0.5)

    def gain(k, shape):
        return 1.0 + 0.01 * jax.random.normal(k, shape, f32)

    x = jax.random.normal(ks[0], (BATCH, SEQ, D_MODEL), f32)
    start = jax.random.randint(ks[1], (BATCH, 1), 0, 64) * CHUNK
    positions = (start + jnp.arange(SEQ, dtype=jnp.int32)[None, :]).astype(jnp.int32)
    return {
        "x": x,
        "positions": positions,
        "attn_norm_g": gain(ks[2], (DEPTH, D_MODEL)),
        "ffn_norm_g": gain(ks[3], (DEPTH, D_MODEL)),
        "final_norm_g": gain(ks[4], (D_MODEL,)),
        "sc_w_in": w(ks[5], (n_conv, D_MODEL, 3 * D_MODEL), D_MODEL),
        "sc_conv_w": w(ks[6], (n_conv, CONV_WIDTH, D_MODEL), CONV_WIDTH),
        "sc_w_out": w(ks[7], (n_conv, D_MODEL, D_MODEL), D_MODEL),
        "mla_wq_a": w(ks[8], (n_mla, D_MODEL, Q_LORA_RANK), D_MODEL),
        "mla_q_norm_g": gain(ks[9], (n_mla, Q_LORA_RANK)),
        "mla_wq_b": w(ks[10], (n_mla, Q_LORA_RANK, N_HEADS * QK_HEAD_DIM), Q_LORA_RANK),
        "mla_wkv_a": w(ks[11], (n_mla, D_MODEL, KV_LORA_RANK + QK_ROPE_DIM), D_MODEL),
        "mla_kv_norm_g": gain(ks[12], (n_mla, KV_LORA_RANK)),
        "mla_wkv_b": w(ks[13], (n_mla, KV_LORA_RANK, N_HEADS * (QK_NOPE_DIM + V_HEAD_DIM)), KV_LORA_RANK),
        "mla_wo": w(ks[14], (n_mla, N_HEADS * V_HEAD_DIM, D_MODEL), N_HEADS * V_HEAD_DIM),
        "ffn_w_gate": w(ks[15], (DEPTH, D_MODEL, D_FF), D_MODEL),
        "ffn_w_up": w(ks[16], (DEPTH, D_MODEL, D_FF), D_MODEL),
        "ffn_conv_w": w(ks[17], (DEPTH, CONV_WIDTH, D_FF), CONV_WIDTH),
        "ffn_conv_b": 0.01 * jax.random.normal(ks[18], (DEPTH, D_FF), f32),
        "ffn_w_down": w(ks[19], (DEPTH, D_FF, D_MODEL), D_FF),
    }


def reference(x, positions, attn_norm_g, ffn_norm_g, final_norm_g,
              sc_w_in, sc_conv_w, sc_w_out,
              mla_wq_a, mla_q_norm_g, mla_wq_b, mla_wkv_a, mla_kv_norm_g, mla_wkv_b, mla_wo,
              ffn_w_gate, ffn_w_up, ffn_conv_w, ffn_conv_b, ffn_w_down):
    cos, sin = rope_cos_sin(positions)
    h = x
    for i in range(DEPTH):
        j = i // N_MIXERS
        hn = rms_norm(h, attn_norm_g[i])
        if i % N_MIXERS == 0:
            mix = short_conv_mixer(hn, sc_w_in[j], sc_conv_w[j], sc_w_out[j])
        else:
            mix = mla_mixer(hn, cos, sin, mla_wq_a[j], mla_q_norm_g[j], mla_wq_b[j],
                            mla_wkv_a[j], mla_kv_norm_g[j], mla_wkv_b[j], mla_wo[j])
        h = h + mix
        h = h + conv_ffn(rms_norm(h, ffn_norm_g[i]), ffn_w_gate[i], ffn_w_up[i],
                         ffn_conv_w[i], ffn_conv_b[i], ffn_w_down[i])
    return rms_norm(h, final_norm_g)
```

```cpp
#include <hip/hip_runtime.h>
#include <cstdio>
#include <cstdint>

#include <type_traits>
#define GAS __attribute__((address_space(1)))
typedef GAS float gfloat; typedef GAS unsigned short gbf16; typedef GAS int gint; typedef GAS unsigned gu32; typedef GAS unsigned char guchar; typedef GAS unsigned long long gu64;
#ifndef MK_PER_PHASE
#define MK_PER_PHASE 0
#endif

namespace pg8 {
#define PG8_LAS __attribute__((address_space(3)))
typedef unsigned short bf16_t;
typedef short bf16x8 __attribute__((ext_vector_type(8)));
typedef float f32x4 __attribute__((ext_vector_type(4)));
typedef float f32x2 __attribute__((ext_vector_type(2)));
typedef unsigned u32x4 __attribute__((ext_vector_type(4)));
typedef unsigned u32x2 __attribute__((ext_vector_type(2)));
constexpr int BM = 256, BK = 64, HALF = 128, HTB = HALF * BK * 2  , STAGE_BYTES = 8 * HTB, NXCD = 8, WGM = 8;

__host__ __device__ __forceinline__ int lds_byte(int r, int c) { const int st = (r >> 4) * 2 + (c >> 5), rr = r & 15, cc = c & 31, ob = rr * 64 + cc * 2; return st * 1024 + (ob ^ (((ob >> 9) & 1) << 5)); }
__host__ __device__ __forceinline__ void stage_rc(int b, int& R, int& C) { const int st = b / 1024, sb = b % 1024, swz = sb ^ (((sb >> 9) & 1) << 5); R = (st >> 1) * 16 + swz / 64; C = (st & 1) * 32 + (swz % 64) / 2; }
__host__ __device__ __forceinline__ int perm32(int rho) { const int n = rho >> 4, i = rho & 15; return 8 * (i >> 2) + 4 * n + (i & 3); }

struct Unit { int pm, pn; };
struct Gemm { const gbf16* A; const gbf16* Bt; int M, N, K, lda, ldb;
    size_t hstepA, tstepA, hstepB, tstepB, pmstepB; };
__device__ __forceinline__ Gemm make_gemm(const gbf16* A, const gbf16* Bt, int M, int N, int K, int lda, int ldb) {
    Gemm g; g.A = A; g.Bt = Bt; g.M = M; g.N = N; g.K = K; g.lda = lda; g.ldb = ldb;
    g.hstepA = (size_t)HALF * lda * 2; g.tstepA = 2 * g.hstepA; g.hstepB = (size_t)HALF * ldb * 2; g.tstepB = 2 * g.hstepB; g.pmstepB = 0; return g; }
struct RowId { __device__ __forceinline__ int operator()(int R) const { return R; } };

struct StaticOrder {
    int nM, nN, nwg, G, c, wgm;
    __host__ __device__ void init(int M, int N, int G_, int c_, int wgm_ = WGM) { nM = M / BM; nN = N / BM; nwg = nM * nN; G = G_; c = c_; wgm = wgm_; }
    __host__ __device__ bool next(int i, Unit& u) const {
        const long L = (long)i * G + c; if (L >= nwg) return false;
        int wgid = (int)L; { const int q = nwg / NXCD, r = nwg % NXCD, xcd = wgid % NXCD, off = wgid / NXCD; wgid = (xcd < r ? xcd * (q + 1) : r * (q + 1) + (xcd - r) * q) + off; }
        const int nig = wgm * nN, gid = wgid / nig, fm = gid * wgm, gsz = (nM - fm) < wgm ? (nM - fm) : wgm;
        u.pm = fm + ((wgid % nig) % gsz); u.pn = (wgid % nig) / gsz; return true;
    }
    __device__ __forceinline__ void a_ready(const Unit&) const {}
    __device__ __forceinline__ void done(const Unit&) const {}
};

__device__ __forceinline__ unsigned cvt_pk_bf16(float lo, float hi) { unsigned r; asm volatile("v_cvt_pk_bf16_f32 %0, %1, %2" : "=v"(r) : "v"(lo), "v"(hi)); return r; }

constexpr float EPS_ = 1e-6f;
constexpr float SSQ_SCALE = 1048576.0f, SSQ_INV = 1.0f / 1048576.0f;
__device__ __forceinline__ unsigned long long ssq_fix(float sq) { return (unsigned long long)(sq * SSQ_SCALE); }
__device__ __forceinline__ void ssq_add(gu64* p, float sq) { (void)__hip_atomic_fetch_add(p, ssq_fix(sq), __ATOMIC_RELAXED, __HIP_MEMORY_SCOPE_AGENT); }
__device__ __forceinline__ float rstd_of(const gu64* ssq, int row, float invn) { const unsigned long long v = ssq[row];
    const float f = __builtin_fmaf((float)(unsigned)(v >> 32), 4294967296.0f, (float)(unsigned)v); return __builtin_amdgcn_rsqf(f * (invn * SSQ_INV) + EPS_); }
__device__ __forceinline__ float sq4(const f32x4 v) { return (v[0] * v[0] + v[1] * v[1]) + (v[2] * v[2] + v[3] * v[3]); }
__device__ __forceinline__ float quad_sum(float v) { v += __shfl_xor(v, 16); v += __shfl_xor(v, 32); return v; }
__device__ __forceinline__ u32x4 pack8(const f32x4 v0, const f32x4 v1) { u32x4 w; w.x = cvt_pk_bf16(v0[0], v0[1]); w.y = cvt_pk_bf16(v0[2], v0[3]); w.z = cvt_pk_bf16(v1[0], v1[1]); w.w = cvt_pk_bf16(v1[2], v1[3]); return w; }

struct EpiVT {
    static constexpr bool PERM = true, AFTER_DRAIN = false, NEEDS_ALIGN = false;
    gbf16* O; int ldc; const gu64* ssq; float invn;
    __device__ __forceinline__ void operator()(const f32x4 (&acc)[2][2][4][2], const Unit& u, int wr, int wc, int fr, int fq) const {
        const int row0 = u.pm * BM + wr * 64 + fr, col0 = u.pn * BM + wc * 32 + 8 * fq;
        f32x4 s0[2], s1[2];
#pragma unroll
        for (int bj = 0; bj < 2; ++bj)
#pragma unroll
            for (int e = 0; e < 4; ++e) { s0[bj][e] = rstd_of(ssq, col0 + bj * HALF + e, invn); s1[bj][e] = rstd_of(ssq, col0 + bj * HALF + 4 + e, invn); }
#pragma unroll
        for (int ai = 0; ai < 2; ++ai)
#pragma unroll
            for (int m = 0; m < 4; ++m) { gbf16* rowp = O + (size_t)(row0 + ai * HALF + m * 16) * ldc + col0;
#pragma unroll
                for (int bj = 0; bj < 2; ++bj) *(GAS u32x4*)(rowp + bj * HALF) = pack8(acc[ai][bj][m][0] * s0[bj], acc[ai][bj][m][1] * s1[bj]); }
    }
};
struct EpiResid {
    static constexpr bool PERM = true, AFTER_DRAIN = false, NEEDS_ALIGN = false;
    gbf16* HB; gu64* ssq; int ldc;
    __device__ __forceinline__ void operator()(const f32x4 (&acc)[2][2][4][2], const Unit& u, int wr, int wc, int fr, int fq) const {
        const int row0 = u.pm * BM + wr * 64 + fr, col0 = u.pn * BM + wc * 32 + 8 * fq;
        u32x4 b[2][4][2];
#pragma unroll
        for (int ai = 0; ai < 2; ++ai)
#pragma unroll
            for (int m = 0; m < 4; ++m)
#pragma unroll
                for (int bj = 0; bj < 2; ++bj) b[ai][m][bj] = *(const GAS u32x4*)(HB + (size_t)(row0 + ai * HALF + m * 16) * ldc + col0 + bj * HALF);
        asm volatile("" ::: "memory");
#pragma unroll
        for (int ai = 0; ai < 2; ++ai)
#pragma unroll
            for (int m = 0; m < 4; ++m) { const int row = row0 + ai * HALF + m * 16; const size_t off = (size_t)row * ldc + col0;
                float sq = 0.f;
#pragma unroll
                for (int bj = 0; bj < 2; ++bj) { const u32x4 bb = b[ai][m][bj];
                    const f32x4 b0 = {__uint_as_float(bb.x << 16), __uint_as_float(bb.x & 0xffff0000u), __uint_as_float(bb.y << 16), __uint_as_float(bb.y & 0xffff0000u)};
                    const f32x4 b1 = {__uint_as_float(bb.z << 16), __uint_as_float(bb.z & 0xffff0000u), __uint_as_float(bb.w << 16), __uint_as_float(bb.w & 0xffff0000u)};
                    const f32x4 o0 = acc[ai][bj][m][0] + b0, o1 = acc[ai][bj][m][1] + b1;
                    *(GAS u32x4*)(HB + off + bj * HALF) = pack8(o0, o1); sq += sq4(o0) + sq4(o1); }
                sq = quad_sum(sq);
                if (fq == 0) ssq_add(ssq + row, sq);
                asm volatile("" ::: "memory"); }
    }
};
struct Row4 { __device__ __forceinline__ int operator()(int R) const { return (R & ~63) | ((R & 15) << 2) | ((R >> 4) & 3); } };
__device__ __forceinline__ float dpp_shr1(float keep, float v) { return __int_as_float(__builtin_amdgcn_update_dpp(__float_as_int(keep), __float_as_int(v), 0x111, 0xf, 0xf, false)); }
__device__ __forceinline__ f32x4 shr1x4(const f32x4 keep, const f32x4 v) { f32x4 r;
#pragma unroll
    for (int e = 0; e < 4; ++e) r[e] = dpp_shr1(keep[e], v[e]);
    return r; }
struct EpiFfn {
    static constexpr bool PERM = true, AFTER_DRAIN = false, NEEDS_ALIGN = true;
    gbf16* ACT; const gu64* ssq; gfloat* save; const gfloat* cw; const gfloat* cb; PG8_LAS float* X; int dff;
    const gfloat* cvG; const gfloat* cvU; const gfloat* cvgain; gbf16* cvdst; PG8_LAS unsigned char* cvscr;
    __device__ __forceinline__ void operator()(const f32x4 (&acc)[2][2][4][2], const Unit& u, int wr, int wc, int fr, int fq) const {
        const int row0 = u.pm * BM + wr * 64 + 4 * fr, lc = wc * 32 + 8 * fq, f0 = u.pn * HALF + lc;
        float s[2][4];
#pragma unroll
        for (int ai = 0; ai < 2; ++ai)
#pragma unroll
            for (int m = 0; m < 4; ++m) s[ai][m] = rstd_of(ssq, row0 + ai * HALF + m, 1.0f / 4096.0f);
        if (fr == 15) {
#pragma unroll
            for (int ai = 0; ai < 2; ++ai)
#pragma unroll
                for (int n = 0; n < 2; ++n) { *(PG8_LAS f32x4*)(X + (((ai * 2 + wr) * 2 + 0) * 128 + lc + 4 * n)) = acc[ai][0][2][n] * s[ai][2];
                                              *(PG8_LAS f32x4*)(X + (((ai * 2 + wr) * 2 + 1) * 128 + lc + 4 * n)) = acc[ai][0][3][n] * s[ai][3]; }
            if (wr == 1) {
#pragma unroll
                for (int n = 0; n < 2; ++n) { *(GAS f32x4*)(save + ((size_t)(0 * 64 + u.pm) * 2 + 0) * dff + f0 + 4 * n) = acc[1][0][2][n] * s[1][2];
                                              *(GAS f32x4*)(save + ((size_t)(0 * 64 + u.pm) * 2 + 1) * dff + f0 + 4 * n) = acc[1][0][3][n] * s[1][3]; }
            }
        }
        if (wr == 0 && fr == 0) {
#pragma unroll
            for (int r = 0; r < 2; ++r)
#pragma unroll
                for (int n = 0; n < 2; ++n) { *(GAS f32x4*)(save + ((size_t)(1 * 64 + u.pm) * 2 + r) * dff + f0 + 4 * n) = acc[0][0][r][n] * s[0][r];
                                              *(GAS f32x4*)(save + ((size_t)(2 * 64 + u.pm) * 2 + r) * dff + f0 + 4 * n) = acc[0][1][r][n] * s[0][r]; }
        }
        f32x4 w0[2], w1[2], w2[2], bb[2];
#pragma unroll
        for (int n = 0; n < 2; ++n) { w0[n] = *(const GAS f32x4*)(cw + f0 + 4 * n); w1[n] = *(const GAS f32x4*)(cw + dff + f0 + 4 * n); w2[n] = *(const GAS f32x4*)(cw + 2 * dff + f0 + 4 * n); bb[n] = *(const GAS f32x4*)(cb + f0 + 4 * n); }
        const bool docv = (cvG != nullptr);
        const int wv = wr * 4 + wc, ln = fq * 16 + fr, clq = ln >> 2, clr = ln & 3;
        int cvhalf = 0, cvk0 = 0, cvn0 = 0; f32x4 cvv[8], cvg = {0.f, 0.f, 0.f, 0.f};
#pragma unroll
        for (int j = 0; j < 8; ++j) cvv[j] = (f32x4){0.f, 0.f, 0.f, 0.f};
        asm volatile("s_waitcnt lgkmcnt(0)" ::: "memory"); __builtin_amdgcn_s_barrier(); asm volatile("" ::: "memory");
#pragma unroll
        for (int ai = 0; ai < 2; ++ai) {
            if (ai == 1 && docv) {
                const int h = (u.pm * 86 + u.pn) * 8 + wv; cvhalf = (h >= 22016) ? 1 : 0; const int idx = h - cvhalf * 22016, kb = idx / 344, cb2 = idx - kb * 344; cvk0 = 64 * kb; cvn0 = 32 * cb2;
                const gfloat* src = cvG + (size_t)cvhalf * (size_t)(cvU - cvG) + (size_t)(cvk0 + 4 * clq) * dff + cvn0 + 4 * clr;
#pragma unroll
                for (int j = 0; j < 8; ++j) cvv[j] = *(const GAS f32x4*)(src + (size_t)(j & 3) * dff + 16 * (j >> 2));
                cvg = *(const GAS f32x4*)(cvgain + cvk0 + 4 * clq);
                asm volatile("" ::: "memory");
            }
            f32x4 p1[2], p2[2];
            if (ai == 0 && wr == 0) {
#pragma unroll
                for (int n = 0; n < 2; ++n) { p1[n] = (f32x4){0.f, 0.f, 0.f, 0.f}; p2[n] = (f32x4){0.f, 0.f, 0.f, 0.f}; }
            } else {
                const int as = ai + wr - 1, ws_ = wr ^ 1;
#pragma unroll
                for (int n = 0; n < 2; ++n) { p2[n] = *(const PG8_LAS f32x4*)(X + (((as * 2 + ws_) * 2 + 0) * 128 + lc + 4 * n)); p1[n] = *(const PG8_LAS f32x4*)(X + (((as * 2 + ws_) * 2 + 1) * 128 + lc + 4 * n)); }
            }
            u32x2 lo[4];
#pragma unroll
            for (int n = 0; n < 2; ++n) {
                f32x4 g[4];
#pragma unroll
                for (int m = 0; m < 4; ++m) g[m] = acc[ai][0][m][n] * s[ai][m];
                const f32x4 d3 = shr1x4(p1[n], g[3]), d2 = shr1x4(p2[n], g[2]);
#pragma unroll
                for (int m = 0; m < 4; ++m) {
                    const f32x4 up1 = (m == 0) ? d3 : g[m == 0 ? 0 : m - 1], up2 = (m == 0) ? d2 : (m == 1) ? d3 : g[m < 2 ? 0 : m - 2], uu = acc[ai][1][m][n] * s[ai][m];
                    const f32x4 cv = __builtin_elementwise_fma(w0[n], up2, __builtin_elementwise_fma(w1[n], up1, __builtin_elementwise_fma(w2[n], g[m], bb[n])));
                    const f32x4 ea = cv * -1.4426950408889634f; f32x4 sg;
#pragma unroll
                    for (int e = 0; e < 4; ++e) sg[e] = __builtin_amdgcn_rcpf(1.0f + __builtin_amdgcn_exp2f(ea[e]));
                    const f32x4 o = cv * sg * uu;
                    if (n == 0) { lo[m].x = cvt_pk_bf16(o[0], o[1]); lo[m].y = cvt_pk_bf16(o[2], o[3]); }
                    else { u32x4 w; w.x = lo[m].x; w.y = lo[m].y; w.z = cvt_pk_bf16(o[0], o[1]); w.w = cvt_pk_bf16(o[2], o[3]);
                           *(GAS u32x4*)(ACT + (size_t)(row0 + ai * HALF + m) * dff + f0) = w; }
                }
            }
        }
        if (docv) {
            PG8_LAS unsigned char* scr = cvscr + wv * 2048;
#pragma unroll
            for (int q = 0; q < 2; ++q) {
#pragma unroll
                for (int e = 0; e < 4; ++e) { u32x2 w; w.x = cvt_pk_bf16(cvv[4 * q + 0][e] * cvg[0], cvv[4 * q + 1][e] * cvg[1]); w.y = cvt_pk_bf16(cvv[4 * q + 2][e] * cvg[2], cvv[4 * q + 3][e] * cvg[3]);
                    *(PG8_LAS u32x2*)(scr + (4 * clr + e) * 128 + clq * 8) = w; }
                asm volatile("s_waitcnt lgkmcnt(0)" ::: "memory");
#pragma unroll
                for (int jj = 0; jj < 2; ++jj) { const int n = (ln >> 3) + 8 * jj, c = ln & 7, gn = cvn0 + 16 * q + n, drow = (gn >> 7) * 256 + cvhalf * 128 + (gn & 127);
                    const u32x4 v = *(const PG8_LAS u32x4*)(scr + n * 128 + c * 16);
                    *(GAS u32x4*)(cvdst + (size_t)drow * 4096 + cvk0 + 8 * c) = v; }
                asm volatile("s_waitcnt lgkmcnt(0)" ::: "memory");
            }
        }
    }
};
struct EpiCv {
    static constexpr bool PERM = true, AFTER_DRAIN = false, NEEDS_ALIGN = true;
    gbf16* CVC; const gu64* ssq; gfloat* save; const gfloat* cw; PG8_LAS float* X; int ldc;
    __device__ __forceinline__ void operator()(f32x4 (&acc)[2][2][4][2], const Unit& u, int wr, int wc, int fr, int fq) const {
        const int row0 = u.pm * BM + wr * 64 + 4 * fr, lc = wc * 32 + 8 * fq, f0 = u.pn * HALF + lc;
#pragma unroll
        for (int ai = 0; ai < 2; ++ai)
#pragma unroll
            for (int m = 0; m < 4; ++m) { const float s = rstd_of(ssq, row0 + ai * HALF + m, 1.0f / 4096.0f), s2 = s * s;
#pragma unroll
                for (int n = 0; n < 2; ++n) acc[ai][0][m][n] = acc[ai][0][m][n] * acc[ai][1][m][n] * s2; }
        if (fr == 15) {
#pragma unroll
            for (int ai = 0; ai < 2; ++ai)
#pragma unroll
                for (int n = 0; n < 2; ++n) { *(PG8_LAS f32x4*)(X + (((ai * 2 + wr) * 2 + 0) * 128 + lc + 4 * n)) = acc[ai][0][2][n];
                                              *(PG8_LAS f32x4*)(X + (((ai * 2 + wr) * 2 + 1) * 128 + lc + 4 * n)) = acc[ai][0][3][n]; }
            if (wr == 1) {
#pragma unroll
                for (int n = 0; n < 2; ++n) { *(GAS f32x4*)(save + ((size_t)(0 * 64 + u.pm) * 2 + 0) * ldc + f0 + 4 * n) = acc[1][0][2][n];
                                              *(GAS f32x4*)(save + ((size_t)(0 * 64 + u.pm) * 2 + 1) * ldc + f0 + 4 * n) = acc[1][0][3][n]; }
            }
        }
        if (wr == 0 && fr == 0) {
#pragma unroll
            for (int r = 0; r < 2; ++r)
#pragma unroll
                for (int n = 0; n < 2; ++n) *(GAS f32x4*)(save + ((size_t)(1 * 64 + u.pm) * 2 + r) * ldc + f0 + 4 * n) = acc[0][0][r][n];
        }
        f32x4 w0[2], w1[2], w2[2];
#pragma unroll
        for (int n = 0; n < 2; ++n) { w0[n] = *(const GAS f32x4*)(cw + f0 + 4 * n); w1[n] = *(const GAS f32x4*)(cw + ldc + f0 + 4 * n); w2[n] = *(const GAS f32x4*)(cw + 2 * ldc + f0 + 4 * n); }
        asm volatile("s_waitcnt lgkmcnt(0)" ::: "memory"); __builtin_amdgcn_s_barrier(); asm volatile("" ::: "memory");
#pragma unroll
        for (int ai = 0; ai < 2; ++ai) {
            f32x4 p1[2], p2[2];
            if (ai == 0 && wr == 0) {
#pragma unroll
                for (int n = 0; n < 2; ++n) { p1[n] = (f32x4){0.f, 0.f, 0.f, 0.f}; p2[n] = (f32x4){0.f, 0.f, 0.f, 0.f}; }
            } else {
                const int as = ai + wr - 1, ws_ = wr ^ 1;
#pragma unroll
                for (int n = 0; n < 2; ++n) { p2[n] = *(const PG8_LAS f32x4*)(X + (((as * 2 + ws_) * 2 + 0) * 128 + lc + 4 * n)); p1[n] = *(const PG8_LAS f32x4*)(X + (((as * 2 + ws_) * 2 + 1) * 128 + lc + 4 * n)); }
            }
            f32x4 d3[2], d2[2];
#pragma unroll
            for (int n = 0; n < 2; ++n) { d3[n] = shr1x4(p1[n], acc[ai][0][3][n]); d2[n] = shr1x4(p2[n], acc[ai][0][2][n]); }
#pragma unroll
            for (int m = 0; m < 4; ++m) {
                f32x4 o[2];
#pragma unroll
                for (int n = 0; n < 2; ++n) { const f32x4 g = acc[ai][0][m][n];
                    const f32x4 up1 = (m == 0) ? d3[n] : acc[ai][0][m == 0 ? 0 : m - 1][n], up2 = (m == 0) ? d2[n] : (m == 1) ? d3[n] : acc[ai][0][m < 2 ? 0 : m - 2][n];
                    o[n] = __builtin_elementwise_fma(w0[n], up2, __builtin_elementwise_fma(w1[n], up1, w2[n] * g)); }
                *(GAS u32x4*)(CVC + (size_t)(row0 + ai * HALF + m) * ldc + f0) = pack8(o[0], o[1]); }
        }
    }
};
struct EpiY {
    static constexpr bool PERM = true, AFTER_DRAIN = false, NEEDS_ALIGN = false;
    gbf16* Y; const gbf16* CVC; const gu64* ssq; int ldc;
    __device__ __forceinline__ void operator()(const f32x4 (&acc)[2][2][4][2], const Unit& u, int wr, int wc, int fr, int fq) const {
        const int row0 = u.pm * BM + wr * 64 + fr, col0 = u.pn * BM + wc * 32 + 8 * fq;
        u32x4 c[2][4][2]; float s[2][4];
#pragma unroll
        for (int ai = 0; ai < 2; ++ai)
#pragma unroll
            for (int m = 0; m < 4; ++m) { const int row = row0 + ai * HALF + m * 16; s[ai][m] = rstd_of(ssq, row, 1.0f / 4096.0f);
#pragma unroll
                for (int bj = 0; bj < 2; ++bj) c[ai][m][bj] = *(const GAS u32x4*)(CVC + (size_t)row * ldc + col0 + bj * HALF); }
        asm volatile("" ::: "memory");
#pragma unroll
        for (int ai = 0; ai < 2; ++ai)
#pragma unroll
            for (int m = 0; m < 4; ++m) { const int row = row0 + ai * HALF + m * 16; const size_t off = (size_t)row * ldc + col0; const float sr = s[ai][m];
#pragma unroll
                for (int bj = 0; bj < 2; ++bj) { const u32x4 cc = c[ai][m][bj];
                    const f32x4 c0 = {__uint_as_float(cc.x << 16), __uint_as_float(cc.x & 0xffff0000u), __uint_as_float(cc.y << 16), __uint_as_float(cc.y & 0xffff0000u)};
                    const f32x4 c1 = {__uint_as_float(cc.z << 16), __uint_as_float(cc.z & 0xffff0000u), __uint_as_float(cc.w << 16), __uint_as_float(cc.w & 0xffff0000u)};
                    *(GAS u32x4*)(Y + off + bj * HALF) = pack8(acc[ai][bj][m][0] * sr * c0, acc[ai][bj][m][1] * sr * c1); } }
    }
};
struct EpiQkva {
    static constexpr bool PERM = true, AFTER_DRAIN = false, NEEDS_ALIGN = false;
    gbf16* QA; gbf16* KR; const gfloat* tab; const gu64* ssq_h; gu64* ssq_q; gu64* ssq_kv;
    __device__ __forceinline__ void operator()(const f32x4 (&acc)[2][2][4][2], const Unit& u, int wr, int wc, int fr, int fq) const {
        const int row0 = u.pm * BM + wr * 64 + fr, col0 = u.pn * BM + wc * 32 + 8 * fq;
        float sv[2][4];
#pragma unroll
        for (int ai = 0; ai < 2; ++ai)
#pragma unroll
            for (int m = 0; m < 4; ++m) sv[ai][m] = rstd_of(ssq_h, row0 + ai * HALF + m * 16, 1.0f / 4096.0f);
        asm volatile("" ::: "memory");
#pragma unroll
        for (int ai = 0; ai < 2; ++ai)
#pragma unroll
            for (int m = 0; m < 4; ++m) { const int row = row0 + ai * HALF + m * 16; const float s = sv[ai][m];
#pragma unroll
                for (int bj = 0; bj < 2; ++bj) { const int c0 = col0 + bj * HALF;
                    f32x4 v0 = acc[ai][bj][m][0] * s, v1 = acc[ai][bj][m][1] * s;
                    if (c0 < 1536) {
                        *(GAS u32x4*)(QA + (size_t)row * 1536 + c0) = pack8(v0, v1);
                        const float sq = quad_sum(sq4(v0) + sq4(v1));
                        if (fq == 0) ssq_add((c0 < 1024 ? ssq_q : ssq_kv) + row, sq);
                    } else if (c0 < 1600) {
                        const int i0 = (c0 - 1536) >> 1; const f32x4 t0 = *(const GAS f32x4*)(tab + (size_t)row * 64 + 2 * i0), t1 = *(const GAS f32x4*)(tab + (size_t)row * 64 + 2 * i0 + 4);
                        f32x4 r0, r1;
                        r0[0] = v0[0] * t0[0] - v0[1] * t0[1]; r0[1] = v0[0] * t0[1] + v0[1] * t0[0]; r0[2] = v0[2] * t0[2] - v0[3] * t0[3]; r0[3] = v0[2] * t0[3] + v0[3] * t0[2];
                        r1[0] = v1[0] * t1[0] - v1[1] * t1[1]; r1[1] = v1[0] * t1[1] + v1[1] * t1[0]; r1[2] = v1[2] * t1[2] - v1[3] * t1[3]; r1[3] = v1[2] * t1[3] + v1[3] * t1[2];
                        *(GAS u32x4*)(KR + (size_t)row * 64 + (c0 - 1536)) = pack8(r0, r1);
                    } } }
    }
};
struct EpiKN {
    static constexpr bool PERM = true, AFTER_DRAIN = false, NEEDS_ALIGN = false;
    gbf16* O; const gbf16* KR; const gu64* ssq; float invn;
    __device__ __forceinline__ void operator()(const f32x4 (&acc)[2][2][4][2], const Unit& u, int wr, int wc, int fr, int fq) const {
        const int row0 = u.pm * BM + wr * 64 + fr, col0 = u.pn * BM + wc * 32 + 8 * fq;
        const int rh = 2 * u.pn + (wc >> 1), rc = ((wc & 1) * 4 + fq) * 8;
        float sv[2][4]; u32x4 krv[2][4];
#pragma unroll
        for (int ai = 0; ai < 2; ++ai)
#pragma unroll
            for (int m = 0; m < 4; ++m) { const int row = row0 + ai * HALF + m * 16; sv[ai][m] = rstd_of(ssq, row, invn); krv[ai][m] = *(const GAS u32x4*)(KR + (size_t)row * 64 + rc); }
        asm volatile("" ::: "memory");
#pragma unroll
        for (int ai = 0; ai < 2; ++ai)
#pragma unroll
            for (int m = 0; m < 4; ++m) { const int row = row0 + ai * HALF + m * 16; gbf16* rowp = O + (size_t)row * (32 * 192);
                const float s = sv[ai][m];
                const u32x4 kr = krv[ai][m];
#pragma unroll
                for (int bj = 0; bj < 2; ++bj) { const int c = col0 + bj * HALF; *(GAS u32x4*)(rowp + (c >> 7) * 192 + (c & 127)) = pack8(acc[ai][bj][m][0] * s, acc[ai][bj][m][1] * s); }
                *(GAS u32x4*)(rowp + rh * 192 + 128 + rc) = kr; }
    }
};
struct EpiQ {
    static constexpr bool PERM = true, AFTER_DRAIN = false, NEEDS_ALIGN = false;
    gbf16* O; int ldc; const gfloat* tab; float sc; const gu64* ssq; float invn;
    __device__ __forceinline__ void operator()(const f32x4 (&acc)[2][2][4][2], const Unit& u, int wr, int wc, int fr, int fq) const {
        const int row0 = u.pm * BM + wr * 64 + fr, col0 = u.pn * BM + wc * 32 + 8 * fq;
        float sv[2][4];
#pragma unroll
        for (int ai = 0; ai < 2; ++ai)
#pragma unroll
            for (int m = 0; m < 4; ++m) sv[ai][m] = sc * rstd_of(ssq, row0 + ai * HALF + m * 16, invn);
        asm volatile("" ::: "memory");
#pragma unroll
        for (int bj = 0; bj < 2; ++bj) {
            const int c0 = col0 + bj * HALF, rem = c0 % 192; const bool rope = rem >= 128; const int i0 = rope ? (rem - 128) >> 1 : 0;
            if (rope) {
#pragma unroll
                for (int ai = 0; ai < 2; ++ai) {
                    f32x4 t0[4], t1[4];
#pragma unroll
                    for (int m = 0; m < 4; ++m) { const int row = row0 + ai * HALF + m * 16;
                        t0[m] = *(const GAS f32x4*)(tab + (size_t)row * 64 + 2 * i0); t1[m] = *(const GAS f32x4*)(tab + (size_t)row * 64 + 2 * i0 + 4); }
                    asm volatile("" ::: "memory");
#pragma unroll
                    for (int m = 0; m < 4; ++m) { const int row = row0 + ai * HALF + m * 16; const float s = sv[ai][m];
                        const f32x4 v0 = acc[ai][bj][m][0], v1 = acc[ai][bj][m][1], a0 = t0[m], a1 = t1[m];
                        f32x4 r0, r1;
                        r0[0] = v0[0] * a0[0] - v0[1] * a0[1]; r0[1] = v0[0] * a0[1] + v0[1] * a0[0];
                        r0[2] = v0[2] * a0[2] - v0[3] * a0[3]; r0[3] = v0[2] * a0[3] + v0[3] * a0[2];
                        r1[0] = v1[0] * a1[0] - v1[1] * a1[1]; r1[1] = v1[0] * a1[1] + v1[1] * a1[0];
                        r1[2] = v1[2] * a1[2] - v1[3] * a1[3]; r1[3] = v1[2] * a1[3] + v1[3] * a1[2];
                        *(GAS u32x4*)(O + (size_t)row * ldc + c0) = pack8(r0 * s, r1 * s); }
                    asm volatile("" ::: "memory"); }
            } else {
#pragma unroll
                for (int ai = 0; ai < 2; ++ai)
#pragma unroll
                    for (int m = 0; m < 4; ++m) { const int row = row0 + ai * HALF + m * 16; const float s = sv[ai][m];
                        *(GAS u32x4*)(O + (size_t)row * ldc + c0) = pack8(acc[ai][bj][m][0] * s, acc[ai][bj][m][1] * s); }
            }
        }
    }
};

template <class Epi, class Sched, bool ALIGN_EPI = false, bool SP2 = false, class AMap = RowId>
__device__ __forceinline__ void gemm_phase(PG8_LAS unsigned char* lds, const Gemm g, const Sched& S, const Epi& E) {
    int tid_ = threadIdx.x; asm volatile("" : "+v"(tid_));
    const int tid = tid_, wid = __builtin_amdgcn_readfirstlane(tid >> 6), lane = tid & 63, wr = wid >> 2, wc = wid & 3, fr = lane & 15, fq = lane >> 4;
    const int K = g.K, nt = K / BK;
    unsigned voffA[2], voffB[2];
#pragma unroll
    for (int i = 0; i < 2; ++i) { int R, C; stage_rc(tid * 16 + i * 8192, R, C); const int Rb = Epi::PERM ? ((R & ~31) + perm32(R & 31)) : R;
        voffA[i] = (unsigned)(AMap()(R) * g.lda + C) * 2u; voffB[i] = (unsigned)(Rb * g.ldb + C) * 2u; }
    const size_t kstep = (size_t)(BK * 2);
    const size_t hstepA = g.hstepA, hstepB = g.hstepB, tstepA = g.tstepA, tstepB = g.tstepB;
    static_assert(ALIGN_EPI || !Epi::NEEDS_ALIGN, "this epilogue has a workgroup barrier: both halves must run it together");
    const unsigned ldsw = (unsigned)wid * 1024u;
    const int aoff = lds_byte(wr * 64 + fr, fq * 8), boff = lds_byte(wc * 32 + fr, fq * 8);
#define PG8_SA(b, h) (((b) * 2 + (h)) * HTB)
#define PG8_SB(b, h) ((4 + (b) * 2 + (h)) * HTB)
    const unsigned lds_u = (unsigned)(__UINTPTR_TYPE__)lds;
#define PG8_STAGE(bufoff, gbase, voff) do { _Pragma("unroll") for (int _i = 0; _i < 2; ++_i) \
        asm volatile("s_mov_b32 m0, %1\n\ts_nop 0\n\tglobal_load_lds_dwordx4 %0, %2" :: "v"((voff)[_i]), "s"(lds_u + (unsigned)(bufoff) + ldsw + _i * 8192u), "s"(gbase) : "memory"); } while (0)
#define PG8_LDA(dst, b, h) do { _Pragma("unroll") for (int m = 0; m < 4; ++m) _Pragma("unroll") for (int k = 0; k < 2; ++k) dst[m][k] = *(const PG8_LAS bf16x8*)(lds + PG8_SA(b, h) + aoff + m * 2048 + k * 1024); } while (0)
#define PG8_LDB(dst, b, h) do { _Pragma("unroll") for (int n = 0; n < 2; ++n) _Pragma("unroll") for (int k = 0; k < 2; ++k) dst[n][k] = *(const PG8_LAS bf16x8*)(lds + PG8_SB(b, h) + boff + n * 2048 + k * 1024); } while (0)
#define PG8_MMA(ai, bj, At, Bt) do { __builtin_amdgcn_s_setprio(1); _Pragma("unroll") for (int m = 0; m < 4; ++m) _Pragma("unroll") for (int n = 0; n < 2; ++n) _Pragma("unroll") for (int k = 0; k < 2; ++k) \
        acc[ai][bj][m][n] = __builtin_amdgcn_mfma_f32_16x16x32_bf16(Bt[n][k], At[m][k], acc[ai][bj][m][n], 0, 0, 0); __builtin_amdgcn_s_setprio(0); } while (0)
#define PG8_WAIT_V(n) asm volatile("s_waitcnt vmcnt(" #n ")" ::: "memory")
#define PG8_WAIT_L(n) asm volatile("s_waitcnt lgkmcnt(" #n ")" ::: "memory")
#define PG8_BAR __builtin_amdgcn_s_barrier()
#define PG8_SCHED __builtin_amdgcn_sched_barrier(0)
    Unit cur, nxt; int ui = 0;
    if (!S.next(0, cur)) return;
    f32x4 acc[2][2][4][2];
#pragma unroll
    for (int a = 0; a < 2; ++a)
#pragma unroll
        for (int b = 0; b < 2; ++b)
#pragma unroll
            for (int m = 0; m < 4; ++m)
#pragma unroll
                for (int n = 0; n < 2; ++n) acc[a][b][m][n] = (f32x4){0.f, 0.f, 0.f, 0.f};
    bf16x8 At[4][2], B0[2][2], B1[2][2];
    const GAS char* cA = (const GAS char*)g.A + (size_t)cur.pm * tstepA; const GAS char* cB = (const GAS char*)g.Bt + (size_t)cur.pn * tstepB + (size_t)cur.pm * g.pmstepB;
    S.a_ready(cur);
    if constexpr (SP2) {
        PG8_STAGE(PG8_SB(0, 0), cB, voffB); PG8_STAGE(PG8_SB(0, 1), cB + hstepB, voffB); PG8_STAGE(PG8_SA(0, 0), cA, voffA); PG8_STAGE(PG8_SA(0, 1), cA + hstepA, voffA);
        if (wr == 1) PG8_BAR;
        PG8_WAIT_V(2); PG8_BAR;
        PG8_STAGE(PG8_SB(1, 0), cB + kstep, voffB); PG8_STAGE(PG8_SA(1, 0), cA + kstep, voffA); PG8_STAGE(PG8_SB(1, 1), cB + hstepB + kstep, voffB);
        PG8_WAIT_V(6); PG8_BAR;
    } else {
        PG8_STAGE(PG8_SB(0, 0), cB, voffB); PG8_STAGE(PG8_SA(0, 0), cA, voffA); PG8_STAGE(PG8_SB(0, 1), cB + hstepB, voffB); PG8_STAGE(PG8_SA(0, 1), cA + hstepA, voffA);
        if (wr == 1) PG8_BAR;
        PG8_WAIT_V(4); PG8_BAR;
        PG8_STAGE(PG8_SB(1, 0), cB + kstep, voffB); PG8_STAGE(PG8_SA(1, 0), cA + kstep, voffA); PG8_STAGE(PG8_SB(1, 1), cB + hstepB + kstep, voffB);
        PG8_WAIT_V(6); PG8_BAR;
    }
    for (;;) {
        const bool has_next = S.next(ui + 1, nxt);
        const GAS char* nA = has_next ? (const GAS char*)g.A + (size_t)nxt.pm * tstepA : cA; const GAS char* nB = has_next ? (const GAS char*)g.Bt + (size_t)nxt.pn * tstepB + (size_t)nxt.pm * g.pmstepB : cB;
        for (int t = 0; t < nt; t += 2) {
            const bool last = (t == nt - 2);
            const GAS char* a1 = cA + (size_t)(t + 1) * kstep;
            const GAS char* a2 = last ? nA : cA + (size_t)(t + 2) * kstep; const GAS char* b2 = last ? nB : cB + (size_t)(t + 2) * kstep;
            const GAS char* a3 = a2 + kstep; const GAS char* b3 = b2 + kstep;
            if (last && has_next) S.a_ready(nxt);
            if constexpr (SP2) {
            PG8_LDB(B0, 0, 0); PG8_LDB(B1, 0, 1); PG8_SCHED; PG8_LDA(At, 0, 0); PG8_STAGE(PG8_SA(1, 1), a1 + hstepA, voffA);
            PG8_WAIT_V(8); PG8_WAIT_L(0); PG8_BAR; PG8_MMA(0, 0, At, B0); PG8_MMA(0, 1, At, B1); PG8_BAR; PG8_SCHED;
            PG8_LDA(At, 0, 1); PG8_STAGE(PG8_SB(0, 0), b2, voffB); PG8_STAGE(PG8_SB(0, 1), b2 + hstepB, voffB); PG8_STAGE(PG8_SA(0, 0), a2, voffA);
            PG8_WAIT_V(8); PG8_WAIT_L(0); PG8_BAR; PG8_MMA(1, 0, At, B0); PG8_MMA(1, 1, At, B1); PG8_BAR; PG8_SCHED;
            PG8_LDB(B0, 1, 0); PG8_LDB(B1, 1, 1); PG8_SCHED; PG8_LDA(At, 1, 0); PG8_STAGE(PG8_SA(0, 1), a2 + hstepA, voffA);
            PG8_WAIT_V(8); PG8_WAIT_L(0); PG8_BAR; PG8_MMA(0, 0, At, B0); PG8_MMA(0, 1, At, B1); PG8_BAR; PG8_SCHED;
            PG8_LDA(At, 1, 1); PG8_STAGE(PG8_SB(1, 0), b3, voffB); PG8_STAGE(PG8_SB(1, 1), b3 + hstepB, voffB); PG8_STAGE(PG8_SA(1, 0), a3, voffA);
            PG8_WAIT_V(8); PG8_WAIT_L(0); PG8_BAR; PG8_MMA(1, 0, At, B0); PG8_MMA(1, 1, At, B1); PG8_BAR; PG8_SCHED;
            } else {
            PG8_LDB(B0, 0, 0); PG8_SCHED; PG8_LDA(At, 0, 0); PG8_STAGE(PG8_SA(1, 1), a1 + hstepA, voffA);
            PG8_WAIT_L(8); PG8_BAR; PG8_WAIT_L(0); PG8_MMA(0, 0, At, B0); PG8_BAR; PG8_SCHED;
            PG8_LDB(B1, 0, 1); PG8_STAGE(PG8_SB(0, 0), b2, voffB);
            PG8_BAR; PG8_WAIT_L(0); PG8_MMA(0, 1, At, B1); PG8_BAR;
            PG8_LDA(At, 0, 1); PG8_STAGE(PG8_SA(0, 0), a2, voffA);
            PG8_BAR; PG8_WAIT_L(0); PG8_MMA(1, 0, At, B0); PG8_BAR; PG8_SCHED;
            PG8_STAGE(PG8_SB(0, 1), b2 + hstepB, voffB);
            PG8_WAIT_V(6); PG8_BAR; PG8_MMA(1, 1, At, B1); PG8_BAR;
            PG8_LDB(B0, 1, 0); PG8_SCHED; PG8_LDA(At, 1, 0); PG8_STAGE(PG8_SA(0, 1), a2 + hstepA, voffA);
            PG8_WAIT_L(8); PG8_BAR; PG8_WAIT_L(0); PG8_MMA(0, 0, At, B0); PG8_BAR; PG8_SCHED;
            PG8_LDB(B1, 1, 1); PG8_STAGE(PG8_SB(1, 0), b3, voffB);
            PG8_BAR; PG8_WAIT_L(0); PG8_MMA(0, 1, At, B1); PG8_BAR;
            PG8_LDA(At, 1, 1); PG8_STAGE(PG8_SA(1, 0), a3, voffA);
            PG8_BAR; PG8_WAIT_L(0); PG8_MMA(1, 0, At, B0); PG8_BAR; PG8_SCHED;
            PG8_STAGE(PG8_SB(1, 1), b3 + hstepB, voffB);
            PG8_WAIT_V(6); PG8_BAR; PG8_MMA(1, 1, At, B1); PG8_BAR;
            }
        }
        if constexpr (ALIGN_EPI) { if (wr == 0) PG8_BAR; }
        E(acc, cur, wr, wc, fr, fq); S.done(cur);
        if (!has_next) break;
#pragma unroll
        for (int a = 0; a < 2; ++a)
#pragma unroll
            for (int b = 0; b < 2; ++b)
#pragma unroll
                for (int m = 0; m < 4; ++m)
#pragma unroll
                    for (int n = 0; n < 2; ++n) acc[a][b][m][n] = (f32x4){0.f, 0.f, 0.f, 0.f};
        cur = nxt; cA = nA; cB = nB; ++ui;
        if constexpr (ALIGN_EPI) { if (wr == 1) PG8_BAR; }
    }
    PG8_WAIT_V(0);
    if constexpr (!ALIGN_EPI) { if (wr == 0) PG8_BAR; }
    PG8_BAR;
#undef PG8_SA
#undef PG8_SB
#undef PG8_STAGE
#undef PG8_LDA
#undef PG8_LDB
#undef PG8_MMA
#undef PG8_WAIT_V
#undef PG8_WAIT_L
#undef PG8_BAR
#undef PG8_SCHED
}
}

constexpr int NWAVES = 8;
constexpr int D = 4096, BATCH = 4, SEQ = 4096, DEPTH = 4, T = BATCH * SEQ;
constexpr int DFF = 11008, NH = 32, QLORA = 1024, KVLORA = 512, NOPE = 128, ROPE = 64, QKD = 192, VD = 128;
constexpr int NQKVA = 1792;
constexpr float NORM_EPS = 1e-6f;
constexpr float QSCALE = 0.07216878364870322f * 1.4426950408889634f;

constexpr size_t MiB = 1u << 20;
constexpr size_t WS_CTL = 0, CTL_ZERO_BYTES = 2 * MiB;
constexpr size_t WS_TAB = 2 * MiB;
constexpr size_t WS_W = 8 * MiB;
constexpr size_t SZ_WIN = (size_t)3 * D * D * 2, SZ_WOUT = (size_t)D * D * 2, SZ_WQKVA = (size_t)NQKVA * D * 2, SZ_WQB = (size_t)NH * QKD * QLORA * 2,
                 SZ_WUK = (size_t)NH * NOPE * KVLORA * 2, SZ_WUV = (size_t)NH * VD * KVLORA * 2, SZ_WO = (size_t)D * D * 2, SZ_WGU = (size_t)2 * DFF * D * 2, SZ_WDN = (size_t)D * DFF * 2;
constexpr size_t SZ_WKVB = SZ_WUK + SZ_WUV;
constexpr size_t WS_WIN = WS_W, WS_WOUT = WS_WIN + 2 * SZ_WIN, WS_WQKVA = WS_WOUT + 2 * SZ_WOUT, WS_WQB = WS_WQKVA + 2 * SZ_WQKVA, WS_WUK = WS_WQB + 2 * SZ_WQB,
                 WS_WUV = WS_WUK + SZ_WUK, WS_WO = WS_WUK + 2 * SZ_WKVB, WS_WGU = WS_WO + 2 * SZ_WO, WS_WDN = WS_WGU + 4 * SZ_WGU, WS_WEND = WS_WDN + 4 * SZ_WDN;
constexpr size_t WS_XN = WS_WEND;
constexpr size_t WS_BIG = WS_XN + (size_t)T * D * 2;
constexpr size_t WS_GU = WS_BIG;
constexpr size_t WS_ACT = WS_GU + (size_t)T * 2 * DFF * 2;
constexpr size_t WS_HALO = WS_ACT + (size_t)T * DFF * 2;
constexpr size_t WS_END = WS_HALO + (size_t)4 * 64 * 2 * DFF * 4;
constexpr size_t WS_CVC = WS_BIG;
constexpr size_t WS_Y = WS_CVC + (size_t)T * D * 2;
static_assert(WS_Y + (size_t)T * D * 2 <= WS_END, "conv overlay");
constexpr size_t WS_QA = WS_BIG;
constexpr size_t WS_KR = WS_QA + (size_t)T * 1536 * 2;
constexpr size_t WS_Q = WS_KR + (size_t)T * ROPE * 2;
constexpr size_t WS_KF = WS_Q + (size_t)T * NH * QKD * 2;
constexpr size_t WS_VT = WS_KF + (size_t)T * NH * QKD * 2;
constexpr size_t WS_O = WS_VT + (size_t)T * NH * VD * 2;
static_assert(WS_O + (size_t)T * D * 2 <= WS_END, "mla overlay");
constexpr size_t WS_SSQ = 65536;
constexpr int SSQ_Q = 9, SSQ_KV = 10;
static_assert(WS_SSQ + 13 * (size_t)T * 8 <= CTL_ZERO_BYTES && WS_TAB + (size_t)T * 64 * 4 <= WS_W, "ssq arrays inside the memset region");
constexpr int CW_TMO = 0, CW_CODE = 1, CW_BAR = 4096;

constexpr int RING_OFF = 0, RING_BYTES = 147456;
constexpr int LDSCTL_OFF = RING_BYTES, MISC_OFF = LDSCTL_OFF + 320, XCH_OFF = LDSCTL_OFF + 1024;
constexpr int LDS_BYTES = 153600;
static_assert(MISC_OFF + 128 <= LDS_BYTES, "LDS map");

#define LAS __attribute__((address_space(3)))
typedef unsigned short bf16;
typedef unsigned v4u __attribute__((ext_vector_type(4)));
typedef unsigned v2u __attribute__((ext_vector_type(2)));
typedef float f32x4 __attribute__((ext_vector_type(4)));
typedef float f32x2 __attribute__((ext_vector_type(2)));
typedef float f32x16 __attribute__((ext_vector_type(16)));
typedef short bf16x8 __attribute__((ext_vector_type(8)));
#define RLX_AGENT __ATOMIC_RELAXED, __HIP_MEMORY_SCOPE_AGENT
#define LDS_WAIT() asm volatile("s_waitcnt lgkmcnt(0)" ::: "memory")
#define VM_WAIT() asm volatile("s_waitcnt vmcnt(0)" ::: "memory")
__device__ __forceinline__ unsigned pk2(float lo, float hi) { return pg8::cvt_pk_bf16(lo, hi); }
__device__ __forceinline__ float bflo(unsigned w) { return __uint_as_float(w << 16); }
__device__ __forceinline__ float bfhi(unsigned w) { return __uint_as_float(w & 0xffff0000u); }

#define XB_TMO      128
#define XB_XCNT(j)  (256  + 64 * (j))
#define XB_XSUB(j)  (1280 + 64 * (j))
#define XB_XGEN(j)  (2304 + 64 * (j))
#define XB_TOP      3328
#define XB_TOPGEN   3392
#define XCD_BAR_WORDS 3456
#define XB_SPIN_CAP (1u << 18)
__device__ __forceinline__ unsigned xb_ld(gu32* p)              { return __hip_atomic_load(p, __ATOMIC_RELAXED, __HIP_MEMORY_SCOPE_AGENT); }
__device__ __forceinline__ unsigned xb_add(gu32* p, unsigned v) { return __hip_atomic_fetch_add(p, v, __ATOMIC_RELAXED, __HIP_MEMORY_SCOPE_AGENT); }
__device__ __forceinline__ unsigned xb_xcc_id() { return (unsigned)__builtin_amdgcn_s_getreg((3 << 11) | 20) & 0xFu; }
#define XB_SPIN(cond, bar) do { unsigned _sp = 0; while (cond) { __builtin_amdgcn_s_sleep(1); \
    if ((++_sp & 255u) == 0u) { if (xb_ld(&(bar)[XB_TMO])) break; if (_sp > XB_SPIN_CAP) { (void)xb_add(&(bar)[XB_TMO], 1u); break; } } } } while (0)
struct XcdBarrier { gu32* bar; unsigned x; volatile LAS unsigned* st; };
__device__ __forceinline__ XcdBarrier xcd_barrier_post(gu32* bar, volatile LAS unsigned* st) {
    XcdBarrier b; b.bar = bar; b.x = xb_xcc_id(); b.st = st;
    if (threadIdx.x == 0) (void)xb_add(&bar[XB_XCNT(b.x)], 1u);
    return b;
}
__device__ __forceinline__ void xcd_barrier_complete(gu32* bar, unsigned x, unsigned& nloc, unsigned& nx) {
    const unsigned G = gridDim.x * gridDim.y * gridDim.z;
    unsigned sum, cnt, mine, sp = 0u;
    for (;;) {
        sum = 0u; cnt = 0u; mine = 0u;
#pragma unroll
        for (unsigned j = 0; j < 16; ++j) { const unsigned c = xb_ld(&bar[XB_XCNT(j)]); sum += c; cnt += (c > 0u) ? 1u : 0u; mine = (j == x) ? c : mine; }
        if (sum == G) break;
        __builtin_amdgcn_s_sleep(1);
        if ((++sp & 255u) == 0u) { if (xb_ld(&bar[XB_TMO])) break; if (sp > XB_SPIN_CAP) { (void)xb_add(&bar[XB_TMO], 1u); break; } }
    }
    nloc = mine > 0u ? mine : 1u; nx = cnt > 0u ? cnt : 1u;
}
__device__ __forceinline__ void xcd_barrier(const XcdBarrier& b) {
    asm volatile("s_waitcnt vmcnt(0)" ::: "memory");
    __syncthreads();
    if (threadIdx.x == 0) {
        gu32* bar = b.bar;
        __builtin_amdgcn_s_waitcnt(0);
        unsigned nloc = b.st[0], nx = b.st[1];
        if (nloc == 0u) { xcd_barrier_complete(bar, b.x, nloc, nx); b.st[0] = nloc; b.st[1] = nx; }
        const unsigned old = xb_add(&bar[XB_XSUB(b.x)], 1u);
        const unsigned gen = old / nloc;
        if (old + 1u == (gen + 1u) * nloc) {
            __builtin_amdgcn_fence(__ATOMIC_RELEASE, "agent");
            asm volatile("s_waitcnt vmcnt(0)" ::: "memory");
            const unsigned og = xb_add(&bar[XB_TOP], 1u);
            const unsigned tg = og / nx;
            if (og + 1u == (tg + 1u) * nx) xb_add(&bar[XB_TOPGEN], 1u);
            else XB_SPIN(xb_ld(&bar[XB_TOPGEN]) == tg, bar);
            __builtin_amdgcn_fence(__ATOMIC_ACQUIRE, "agent");
            xb_add(&bar[XB_XGEN(b.x)], 1u);
            asm volatile("s_waitcnt vmcnt(0)" ::: "memory");
        } else {
            XB_SPIN(xb_ld(&bar[XB_XGEN(b.x)]) == gen, bar);
            __builtin_amdgcn_fence(__ATOMIC_ACQUIRE, "agent");
            asm volatile("s_waitcnt vmcnt(0)" ::: "memory");
        }
    }
    __syncthreads();
}

__device__ __forceinline__ float wave_sum(float v) {
#pragma unroll
    for (int o = 1; o < 64; o <<= 1) v += __shfl_xor(v, o);
    return v;
}

struct RowPlain { int off; __device__ __forceinline__ int operator()(int n) const { return n + off; } };
struct RowKva { __device__ __forceinline__ int operator()(int n) const { if (n < KVLORA) return QLORA + n; const int i = n - KVLORA; return QLORA + KVLORA + 2 * (i & 31) + (i >> 5); } };
struct RowQb { __device__ __forceinline__ int operator()(int n) const { const int hh = n / QKD, r = n % QKD; if (r < NOPE) return n; const int i = r - NOPE; return hh * QKD + NOPE + 2 * (i & 31) + (i >> 5); } };
struct RowKvb { __device__ __forceinline__ int operator()(int n) const { const int hh = n >> 8, r = n & 255; return (r >> 7) * (NH * NOPE) + hh * 128 + (r & 127); } };
struct RowCvb { __device__ __forceinline__ int operator()(int n) const { if (n < 4096) return 8192 + n; const int j = (n - 4096) & 4095, v = (n - 4096) >> 12; return (j >> 7) * 256 + v * 128 + (j & 127); } };
struct RowGu { int half; __device__ __forceinline__ int operator()(int n) const { return (n >> 7) * 256 + half * 128 + (n & 127); } };
template <class RowFn>
__device__ __forceinline__ void transpose_cols(const gfloat* W, int K, int ld, int ncols, const RowFn rowfn, const gfloat* gain, gbf16* WT, LAS unsigned char* scr, int gw, int NGW, int lane) {
    const int ncb = ncols / 64, items = (K / 64) * ncb, lq = lane >> 4, lr = lane & 15;
    for (int it = gw; it < items; it += NGW) {
        const int kb = it / ncb, cb = it - kb * ncb, k0 = 64 * kb, n0 = 64 * cb;
        const gfloat* src = W + (size_t)(k0 + 16 * lq) * ld + n0 + 4 * lr;
        f32x4 v[16];
#pragma unroll
        for (int i = 0; i < 16; ++i) v[i] = *(const GAS f32x4*)(src + (size_t)i * ld);
        if (gain) {
#pragma unroll
            for (int i4 = 0; i4 < 4; ++i4) { const f32x4 g = *(const GAS f32x4*)(gain + k0 + 16 * lq + 4 * i4);
                v[4 * i4 + 0] = v[4 * i4 + 0] * g.x; v[4 * i4 + 1] = v[4 * i4 + 1] * g.y; v[4 * i4 + 2] = v[4 * i4 + 2] * g.z; v[4 * i4 + 3] = v[4 * i4 + 3] * g.w; }
        }
#pragma unroll
        for (int e = 0; e < 4; ++e) {
            v4u a, b;
            a.x = pk2(v[0][e], v[1][e]); a.y = pk2(v[2][e], v[3][e]); a.z = pk2(v[4][e], v[5][e]); a.w = pk2(v[6][e], v[7][e]);
            b.x = pk2(v[8][e], v[9][e]); b.y = pk2(v[10][e], v[11][e]); b.z = pk2(v[12][e], v[13][e]); b.w = pk2(v[14][e], v[15][e]);
            LAS unsigned char* rowp = scr + (4 * lr + e) * 128;
            *(LAS v4u*)(rowp + (((2 * lq) ^ (lr & 7)) << 4)) = a; *(LAS v4u*)(rowp + (((2 * lq + 1) ^ (lr & 7)) << 4)) = b;
        }
        LDS_WAIT(); asm volatile("" ::: "memory");
        const int c = lane & 7;
#pragma unroll
        for (int j = 0; j < 8; ++j) { const int n = (lane >> 3) + 8 * j;
            const v4u o = *(const LAS v4u*)(scr + n * 128 + ((c ^ ((n >> 2) & 7)) << 4));
            *(GAS v4u*)(WT + (size_t)rowfn(n0 + n) * K + k0 + 8 * c) = o; }
        LDS_WAIT(); asm volatile("" ::: "memory");
    }
}

__device__ __forceinline__ void unpack8(const v4u w, float (&f)[8]) {
    f[0] = bflo(w.x); f[1] = bfhi(w.x); f[2] = bflo(w.y); f[3] = bfhi(w.y); f[4] = bflo(w.z); f[5] = bfhi(w.z); f[6] = bflo(w.w); f[7] = bfhi(w.w);
}
__device__ __forceinline__ v4u pack8(const float (&f)[8]) { v4u w; w.x = pk2(f[0], f[1]); w.y = pk2(f[2], f[3]); w.z = pk2(f[4], f[5]); w.w = pk2(f[6], f[7]); return w; }

__device__ __forceinline__ void conv_fixup_phase(const gfloat* save, const gfloat* cw, gbf16* CVC, int gtid, int NT_) {
    constexpr int C4 = D / 4, NITEM = 64 * 2 * C4;
    for (int it = gtid; it < NITEM; it += NT_) {
        const int c4 = it % C4, pr = it / C4, r = pr & 1, p = pr >> 1;
        if ((p & 15) == 0) continue;
        const GAS f32x4* prev = (const GAS f32x4*)(save + ((size_t)(0 * 64 + p - 1) * 2) * D) + c4;
        const GAS f32x4* cs = (const GAS f32x4*)(save + ((size_t)(1 * 64 + p) * 2) * D) + c4;
        const f32x4 gm2 = r ? prev[C4] : prev[0], gm1 = r ? cs[0] : prev[C4], gc = r ? cs[C4] : cs[0];
        const f32x4 w0 = *((const GAS f32x4*)cw + c4), w1 = *((const GAS f32x4*)(cw + D) + c4), w2 = *((const GAS f32x4*)(cw + 2 * D) + c4);
        const f32x4 o = w0 * gm2 + w1 * gm1 + w2 * gc;
        v2u w; w.x = pk2(o[0], o[1]); w.y = pk2(o[2], o[3]);
        *((GAS v2u*)(CVC + (size_t)(p * 256 + r) * D) + c4) = w;
    }
}

__device__ __forceinline__ void ffn_fixup_phase(const gfloat* save, const gfloat* cw, const gfloat* cb, gbf16* ACT, int gtid, int NT_) {
    constexpr int C4 = DFF / 4, NITEM = 64 * 2 * C4;
    for (int it = gtid; it < NITEM; it += NT_) {
        const int c4 = it % C4, pr = it / C4, r = pr & 1, p = pr >> 1;
        if ((p & 15) == 0) continue;
        const GAS f32x4* prev = (const GAS f32x4*)(save + ((size_t)(0 * 64 + p - 1) * 2) * DFF) + c4;
        const GAS f32x4* gs = (const GAS f32x4*)(save + ((size_t)(1 * 64 + p) * 2) * DFF) + c4;
        const GAS f32x4* us = (const GAS f32x4*)(save + ((size_t)(2 * 64 + p) * 2) * DFF) + c4;
        const f32x4 gm2 = r ? prev[C4] : prev[0], gm1 = r ? gs[0] : prev[C4], gc = r ? gs[C4] : gs[0], uu = r ? us[C4] : us[0];
        const f32x4 w0 = *((const GAS f32x4*)cw + c4), w1 = *((const GAS f32x4*)(cw + DFF) + c4), w2 = *((const GAS f32x4*)(cw + 2 * DFF) + c4), bb = *((const GAS f32x4*)cb + c4);
        float o[4];
#pragma unroll
        for (int e = 0; e < 4; ++e) { const float cv = w0[e] * gm2[e] + w1[e] * gm1[e] + w2[e] * gc[e] + bb[e];
            o[e] = cv * __builtin_amdgcn_rcpf(1.0f + __builtin_amdgcn_exp2f(cv * -1.4426950408889634f)) * uu[e]; }
        v2u w; w.x = pk2(o[0], o[1]); w.y = pk2(o[2], o[3]);
        *((GAS v2u*)(ACT + (size_t)(p * 256 + r) * DFF) + c4) = w;
    }
}

namespace attn {
constexpr int KROW = 384, VROW = 128, KBUF = 64 * KROW, VBUF = 128 * VROW, NKS = 4, NVS = 3, LDS_V = NKS * KBUF, LDS_TOTAL = NKS * KBUF + NVS * VBUF;
constexpr int KPIECES = KBUF / 1024, VPIECES = VBUF / 1024;
static_assert(KPIECES == 24 && VPIECES == 16 && LDS_TOTAL <= RING_BYTES, "attention LDS");
constexpr float THR = 8.f;
struct Tensors { const gbf16* Q; const gbf16* KF; const gbf16* VT; gbf16* O; };
__device__ __forceinline__ float pair_max(float v) { auto rr = __builtin_amdgcn_permlane32_swap(__float_as_uint(v), __float_as_uint(v), false, false); return fmaxf(__uint_as_float(rr[0]), __uint_as_float(rr[1])); }
__device__ __forceinline__ float pair_sum(float v) { auto rr = __builtin_amdgcn_permlane32_swap(__float_as_uint(v), __float_as_uint(v), false, false); return __uint_as_float(rr[0]) + __uint_as_float(rr[1]); }
#define ATT_SB() __builtin_amdgcn_sched_barrier(0)

__device__ __forceinline__ void qk_tile(f32x16& p0, f32x16& p1, const LAS unsigned char* ks, const unsigned (&kx)[4], const bf16x8 (&qf)[12], float base) {
#pragma unroll
    for (int r = 0; r < 16; ++r) { p0[r] = -base; p1[r] = -base; }
    bf16x8 ka[2][2], kc[2][2];
#pragma unroll
    for (int s = 0; s < 2; ++s) { ka[0][s] = *(const LAS bf16x8*)(ks + kx[s]); kc[0][s] = *(const LAS bf16x8*)(ks + kx[s] + 32 * KROW); }
    ATT_SB();
#pragma unroll
    for (int g = 0; g < 6; ++g) {
        if (g < 5) {
#pragma unroll
            for (int s = 0; s < 2; ++s) { const int st = 2 * g + 2 + s;
                ka[(g + 1) & 1][s] = *(const LAS bf16x8*)(ks + kx[st & 3] + 128 * (st >> 2)); kc[(g + 1) & 1][s] = *(const LAS bf16x8*)(ks + kx[st & 3] + 128 * (st >> 2) + 32 * KROW); }
        }
#pragma unroll
        for (int s = 0; s < 2; ++s) { p0 = __builtin_amdgcn_mfma_f32_32x32x16_bf16(ka[g & 1][s], qf[2 * g + s], p0, 0, 0, 0); p1 = __builtin_amdgcn_mfma_f32_32x32x16_bf16(kc[g & 1][s], qf[2 * g + s], p1, 0, 0, 0); }
        ATT_SB();
    }
}
__device__ __forceinline__ void softmax_tile(f32x16& p0, f32x16& p1, f32x16 (&o)[4], float& m_run, float& l_run, bf16x8 (&pb)[2][2], float base) {
    float pm = p0[0];
#pragma unroll
    for (int r = 1; r < 16; ++r) pm = fmaxf(pm, p0[r]);
#pragma unroll
    for (int r = 0; r < 16; ++r) pm = fmaxf(pm, p1[r]);
    pm = pair_max(pm) + base;
    if (!__all(pm - m_run <= THR)) {
        const float m_new = fmaxf(m_run, pm), alpha = __builtin_amdgcn_exp2f(m_run - m_new), sh = m_new - base; m_run = m_new; l_run *= alpha;
#pragma unroll
        for (int d = 0; d < 4; ++d)
#pragma unroll
            for (int r = 0; r < 16; ++r) o[d][r] *= alpha;
#pragma unroll
        for (int r = 0; r < 16; ++r) { p0[r] -= sh; p1[r] -= sh; }
    }
    f32x2 ps = {0.f, 0.f};
#pragma unroll
    for (int r = 0; r < 16; r += 2) { p0[r] = __builtin_amdgcn_exp2f(p0[r]); p0[r + 1] = __builtin_amdgcn_exp2f(p0[r + 1]); ps += (f32x2){p0[r], p0[r + 1]}; }
#pragma unroll
    for (int r = 0; r < 16; r += 2) { p1[r] = __builtin_amdgcn_exp2f(p1[r]); p1[r + 1] = __builtin_amdgcn_exp2f(p1[r + 1]); ps += (f32x2){p1[r], p1[r + 1]}; }
    l_run += ps.x + ps.y;
#pragma unroll
    for (int s = 0; s < 2; ++s) {
        v4u w0, w1;
        w0.x = pk2(p0[8 * s + 0], p0[8 * s + 1]); w0.y = pk2(p0[8 * s + 2], p0[8 * s + 3]); w0.z = pk2(p0[8 * s + 4], p0[8 * s + 5]); w0.w = pk2(p0[8 * s + 6], p0[8 * s + 7]);
        w1.x = pk2(p1[8 * s + 0], p1[8 * s + 1]); w1.y = pk2(p1[8 * s + 2], p1[8 * s + 3]); w1.z = pk2(p1[8 * s + 4], p1[8 * s + 5]); w1.w = pk2(p1[8 * s + 6], p1[8 * s + 7]);
        pb[0][s] = __builtin_bit_cast(bf16x8, w0); pb[1][s] = __builtin_bit_cast(bf16x8, w1);
    }
}
__device__ __forceinline__ void pv_tile(f32x16 (&o)[4], const LAS unsigned char* vs, const unsigned (&vx)[4], const bf16x8 (&pb)[2][2]) {
    bf16x8 va[2][4];
#pragma unroll
    for (int i = 0; i < 4; ++i) va[0][i] = *(const LAS bf16x8*)(vs + vx[i]);
    ATT_SB();
#pragma unroll
    for (int db = 0; db < 4; ++db) {
        if (db < 3) {
#pragma unroll
            for (int i = 0; i < 4; ++i) va[(db + 1) & 1][i] = *(const LAS bf16x8*)(vs + vx[i] + (db + 1) * 32 * VROW);
        }
#pragma unroll
        for (int i = 0; i < 4; ++i) o[db] = __builtin_amdgcn_mfma_f32_32x32x16_bf16(va[db & 1][i], pb[i >> 1][i & 1], o[db], 0, 0, 0);
        ATT_SB();
    }
}

__device__ __forceinline__ void pv_half(f32x16 (&o)[4], const LAS unsigned char* vs, const unsigned (&vx)[4], const bf16x8 (&pbh)[2], int i0) {
    bf16x8 va[2][2];
#pragma unroll
    for (int i = 0; i < 2; ++i) va[0][i] = *(const LAS bf16x8*)(vs + vx[i0 + i]);
    ATT_SB();
#pragma unroll
    for (int db = 0; db < 4; ++db) {
        if (db < 3) {
#pragma unroll
            for (int i = 0; i < 2; ++i) va[(db + 1) & 1][i] = *(const LAS bf16x8*)(vs + vx[i0 + i] + (db + 1) * 32 * VROW);
        }
#pragma unroll
        for (int i = 0; i < 2; ++i) o[db] = __builtin_amdgcn_mfma_f32_32x32x16_bf16(va[db & 1][i], pbh[i], o[db], 0, 0, 0);
        ATT_SB();
    }
}
__device__ __forceinline__ void qk_block(f32x16& p, const LAS unsigned char* kb, const unsigned (&kx)[4], const bf16x8 (&qf)[12], float base) {
#pragma unroll
    for (int r = 0; r < 16; ++r) p[r] = -base;
    bf16x8 kf[2][4];
#pragma unroll
    for (int i = 0; i < 4; ++i) kf[0][i] = *(const LAS bf16x8*)(kb + kx[i]);
    ATT_SB();
#pragma unroll
    for (int g = 0; g < 3; ++g) {
        if (g < 2) {
#pragma unroll
            for (int i = 0; i < 4; ++i) kf[(g + 1) & 1][i] = *(const LAS bf16x8*)(kb + kx[i] + 128 * (g + 1));
        }
#pragma unroll
        for (int i = 0; i < 4; ++i) p = __builtin_amdgcn_mfma_f32_32x32x16_bf16(kf[g & 1][i], qf[4 * g + i], p, 0, 0, 0);
        ATT_SB();
    }
}
__device__ __forceinline__ void softmax_half(f32x16& p, f32x16 (&o)[4], float& m_run, float& l_run, bf16x8 (&pbh)[2], float base) {
    float pm = p[0];
#pragma unroll
    for (int r = 1; r < 16; ++r) pm = fmaxf(pm, p[r]);
    pm = pair_max(pm) + base;
    if (!__all(pm - m_run <= THR) || !__all(base == m_run)) {
        const float m_new = fmaxf(m_run, pm), alpha = __builtin_amdgcn_exp2f(m_run - m_new), sh = m_new - base; m_run = m_new; l_run *= alpha;
#pragma unroll
        for (int d = 0; d < 4; ++d)
#pragma unroll
            for (int r = 0; r < 16; ++r) o[d][r] *= alpha;
#pragma unroll
        for (int r = 0; r < 16; ++r) p[r] -= sh;
    }
    f32x2 ps = {0.f, 0.f};
#pragma unroll
    for (int r = 0; r < 16; r += 2) { p[r] = __builtin_amdgcn_exp2f(p[r]); p[r + 1] = __builtin_amdgcn_exp2f(p[r + 1]); ps += (f32x2){p[r], p[r + 1]}; }
    l_run += ps.x + ps.y;
#pragma unroll
    for (int s = 0; s < 2; ++s) { v4u w;
        w.x = pk2(p[8 * s + 0], p[8 * s + 1]); w.y = pk2(p[8 * s + 2], p[8 * s + 3]); w.z = pk2(p[8 * s + 4], p[8 * s + 5]); w.w = pk2(p[8 * s + 6], p[8 * s + 7]);
        pbh[s] = __builtin_bit_cast(bf16x8, w); }
}
__device__ __forceinline__ void qk_block_sm(f32x16& pq, const LAS unsigned char* kb, const unsigned (&kx)[4], const bf16x8 (&qf)[12], float base,
                                            f32x16& pa, f32x16 (&o)[4], float& m_run, float& l_run, bf16x8 (&pbh)[2]) {
#pragma unroll
    for (int r = 0; r < 16; ++r) pq[r] = -base;
    bf16x8 kf[2][4];
#pragma unroll
    for (int i = 0; i < 4; ++i) kf[0][i] = *(const LAS bf16x8*)(kb + kx[i]);
    ATT_SB();
#pragma unroll
    for (int i = 0; i < 4; ++i) kf[1][i] = *(const LAS bf16x8*)(kb + kx[i] + 128);
    float mq[4];
#pragma unroll
    for (int i = 0; i < 4; ++i) { pq = __builtin_amdgcn_mfma_f32_32x32x16_bf16(kf[0][i], qf[i], pq, 0, 0, 0);
        mq[i] = fmaxf(fmaxf(pa[4 * i], pa[4 * i + 1]), fmaxf(pa[4 * i + 2], pa[4 * i + 3])); ATT_SB(); }
    float pm = pair_max(fmaxf(fmaxf(mq[0], mq[1]), fmaxf(mq[2], mq[3]))) + base;
    if (!__all(pm - m_run <= THR) || !__all(base == m_run)) {
        const float m_new = fmaxf(m_run, pm), alpha = __builtin_amdgcn_exp2f(m_run - m_new), sh = m_new - base; m_run = m_new; l_run *= alpha;
#pragma unroll
        for (int d = 0; d < 4; ++d)
#pragma unroll
            for (int r = 0; r < 16; ++r) o[d][r] *= alpha;
#pragma unroll
        for (int r = 0; r < 16; ++r) pa[r] -= sh;
    }
    ATT_SB();
#pragma unroll
    for (int i = 0; i < 4; ++i) kf[0][i] = *(const LAS bf16x8*)(kb + kx[i] + 256);
    f32x2 ps = {0.f, 0.f};
#pragma unroll
    for (int i = 0; i < 4; ++i) { pq = __builtin_amdgcn_mfma_f32_32x32x16_bf16(kf[1][i], qf[4 + i], pq, 0, 0, 0);
        pa[4 * i] = __builtin_amdgcn_exp2f(pa[4 * i]); pa[4 * i + 1] = __builtin_amdgcn_exp2f(pa[4 * i + 1]); pa[4 * i + 2] = __builtin_amdgcn_exp2f(pa[4 * i + 2]); pa[4 * i + 3] = __builtin_amdgcn_exp2f(pa[4 * i + 3]);
        ps += (f32x2){pa[4 * i], pa[4 * i + 1]}; ps += (f32x2){pa[4 * i + 2], pa[4 * i + 3]}; ATT_SB(); }
    l_run += ps.x + ps.y;
    v4u w[2];
#pragma unroll
    for (int i = 0; i < 4; ++i) { pq = __builtin_amdgcn_mfma_f32_32x32x16_bf16(kf[0][i], qf[8 + i], pq, 0, 0, 0);
        const unsigned lo_ = pk2(pa[4 * i], pa[4 * i + 1]), hi_ = pk2(pa[4 * i + 2], pa[4 * i + 3]);
        if ((i & 1) == 0) { w[i >> 1].x = lo_; w[i >> 1].y = hi_; } else { w[i >> 1].z = lo_; w[i >> 1].w = hi_; }
        ATT_SB(); }
    pbh[0] = __builtin_bit_cast(bf16x8, w[0]); pbh[1] = __builtin_bit_cast(bf16x8, w[1]);
}
__device__ __forceinline__ void unit(LAS unsigned char* lds, const Tensors& X, int b, int h, int qb, int wid, int lane) {
    const int r32 = lane & 31, hi = lane >> 5, grp = 0;
    const size_t row_q = (size_t)b * SEQ + qb * 256 + wid * 32 + r32;
    bf16x8 qf[12];
    { const gbf16* qp = X.Q + row_q * (NH * QKD) + h * QKD + hi * 8;
#pragma unroll
      for (int s = 0; s < 12; ++s) qf[s] = *(const GAS bf16x8*)(qp + 16 * s); }
    const int ntile = 4 * qb + 4, my_last = 4 * qb + (wid >> 1);
    unsigned koff[3], voff[2];
#pragma unroll
    for (int i = 0; i < 3; ++i) { const int ch = 64 * (wid + 8 * i) + lane, row = ch / 24, cp = ch % 24, c = (cp & ~7) | ((cp ^ (row >> 1)) & 7); koff[i] = (unsigned)(row * (NH * QKD * 2) + c * 16); }
#pragma unroll
    for (int i = 0; i < 2; ++i) { const int ch = 64 * (wid + 8 * i) + lane, d = ch >> 3, cp = ch & 7, c = (cp ^ (d >> 1)) & 7; voff[i] = (unsigned)(d * (T * 2) + c * 16); }
    const GAS char* kbase = (const GAS char*)X.KF + ((size_t)b * SEQ * (NH * QKD) + h * QKD) * 2;
    const GAS char* vbase = (const GAS char*)X.VT + ((size_t)h * VD * T + (size_t)b * SEQ) * 2;
    const unsigned lds_u = (unsigned)(__UINTPTR_TYPE__)lds;
#define ATT_ISSUE_K(tile, slot) do { const GAS char* kb_ = kbase + (size_t)(tile) * (64 * NH * QKD * 2); _Pragma("unroll") for (int i_ = 0; i_ < 3; ++i_) \
        asm volatile("s_mov_b32 m0, %1\n\ts_nop 0\n\tglobal_load_lds_dwordx4 %0, %2" :: "v"(koff[i_]), "s"(lds_u + (unsigned)((slot) * KBUF + (wid + 8 * i_) * 1024)), "s"(kb_) : "memory"); } while (0)
#define ATT_ISSUE_V(tile, slot) do { const GAS char* vb_ = vbase + (size_t)(tile) * 128; _Pragma("unroll") for (int i_ = 0; i_ < 2; ++i_) \
        asm volatile("s_mov_b32 m0, %1\n\ts_nop 0\n\tglobal_load_lds_dwordx4 %0, %2" :: "v"(voff[i_]), "s"(lds_u + (unsigned)(LDS_V + (slot) * VBUF + (wid + 8 * i_) * 1024)), "s"(vb_) : "memory"); } while (0)
#define ATT_SYNC_ISSUE(j_) do { \
        if ((j_) + 2 < ntile) asm volatile("s_waitcnt vmcnt(5)" ::: "memory"); else if ((j_) + 1 < ntile) asm volatile("s_waitcnt vmcnt(2)" ::: "memory"); else asm volatile("s_waitcnt vmcnt(0)" ::: "memory"); \
        __builtin_amdgcn_s_barrier(); asm volatile("" ::: "memory"); \
        if ((j_) + 3 < ntile) ATT_ISSUE_K((j_) + 3, (sk + 3) & 3); if ((j_) + 2 < ntile) ATT_ISSUE_V((j_) + 2, sv2); } while (0)
    f32x16 o[4];
#pragma unroll
    for (int d = 0; d < 4; ++d)
#pragma unroll
        for (int r = 0; r < 16; ++r) o[d][r] = 0.f;
    float m_run = -1e30f, l_run = 0.f, base = 0.f;
    f32x16 p0, p1;
#pragma unroll
    for (int r = 0; r < 16; ++r) { p0[r] = 0.f; p1[r] = 0.f; }
    ATT_ISSUE_K(0, 0); ATT_ISSUE_V(0, 0); ATT_ISSUE_K(1, 1); ATT_ISSUE_K(2, 2); ATT_ISSUE_V(1, 1);
    asm volatile("s_waitcnt vmcnt(5)" ::: "memory"); __builtin_amdgcn_s_barrier(); asm volatile("" ::: "memory");
    const int pi = (r32 & ~0xC) | ((r32 & 4) << 1) | ((r32 & 8) >> 1), gk = (pi >> 1) & 7, gv = (r32 >> 1) & 7;
    unsigned kx[4], vx[4];
#pragma unroll
    for (int i = 0; i < 4; ++i) { kx[i] = (unsigned)(pi * KROW + (((2 * i + hi) ^ gk) & 7) * 16); vx[i] = (unsigned)(LDS_V + r32 * VROW + (((2 * i + hi) ^ gv) & 7) * 16); }
    int sk = 0, sv = 0;
    bf16x8 pb[2][2];
#pragma unroll
    for (int a = 0; a < 2; ++a)
#pragma unroll
        for (int c = 0; c < 2; ++c) pb[a][c] = (bf16x8){0, 0, 0, 0, 0, 0, 0, 0};
    for (int j = 0; j <= ntile; ++j) {
        const int sv1 = (sv == 0) ? 2 : sv - 1, sv2 = (sv == 0) ? 2 : sv - 1;
        if (j >= 1 && j - 1 <= my_last) {
            softmax_half(p1, o, m_run, l_run, pb[1], base);
            pv_half(o, lds + sv1 * VBUF, vx, pb[1], 2);
        }
        ATT_SYNC_ISSUE(j);
        if (j < ntile && j <= my_last) { base = (j == 0) ? 0.f : m_run;
            qk_block(p0, lds + sk * KBUF, kx, qf, base);
            qk_block_sm(p1, lds + sk * KBUF + 32 * KROW, kx, qf, base, p0, o, m_run, l_run, pb[0]);
            pv_half(o, lds + sv * VBUF, vx, pb[0], 0); }
        sk = (sk + 1) & 3; sv = (sv == 2) ? 0 : sv + 1;
    }
#undef ATT_ISSUE_K
#undef ATT_ISSUE_V
#undef ATT_SYNC_ISSUE
    const float inv = 1.0f / pair_sum(l_run);
    gbf16* op = X.O + row_q * D + h * VD + 4 * hi;
#pragma unroll
    for (int db = 0; db < 4; ++db)
#pragma unroll
        for (int g = 0; g < 4; ++g) { v2u w; w.x = pk2(o[db][4 * g + 0] * inv, o[db][4 * g + 1] * inv); w.y = pk2(o[db][4 * g + 2] * inv, o[db][4 * g + 3] * inv);
            *(GAS v2u*)(op + 32 * db + 8 * g) = w; }
}
__device__ __forceinline__ void phase(LAS unsigned char* lds, const Tensors& X, int vcu, int G, int wid, int lane) {
    for (int p2 = 2 * vcu; p2 < BATCH * NH * 16; p2 += ((p2 & 1) ? 2 * G - 1 : 1)) {
        const int p = p2 >> 1, bh = p >> 3, qq = p & 7, b = bh / NH, h = bh % NH;
        unit(lds, X, b, h, (p2 & 1) ? qq : 15 - qq, wid, lane);
    }
}
}

__device__ const double INVF[32] = {1.0, 0.7498942093324559, 0.5623413251903491, 0.4216965034285822, 0.31622776601683794, 0.23713737056616552, 0.1778279410038923, 0.1333521432163324,
    0.1, 0.07498942093324558, 0.05623413251903491, 0.042169650342858224, 0.03162277660168379, 0.023713737056616554, 0.01778279410038923, 0.01333521432163324,
    0.01, 0.007498942093324558, 0.005623413251903491, 0.004216965034285823, 0.0031622776601683794, 0.0023713737056616554, 0.0017782794100389228, 0.001333521432163324,
    0.001, 0.0007498942093324559, 0.0005623413251903491, 0.00042169650342858224, 0.00031622776601683794, 0.00023713737056616554, 0.00017782794100389227, 0.0001333521432163324};
struct Args {
    const float* x; const int* pos; const float* attn_g; const float* ffn_g; const float* final_g;
    const float* sc_w_in; const float* sc_conv_w; const float* sc_w_out;
    const float* wq_a; const float* q_g; const float* wq_b; const float* wkv_a; const float* kv_g; const float* wkv_b; const float* wo;
    const float* w_gate; const float* w_up; const float* f_conv_w; const float* f_conv_b; const float* w_down;
    float* out; unsigned char* ws; int ph_lo, ph_hi;
};
constexpr int PH_PER_LAYER = 10, PH_FINAL = 1 + DEPTH * PH_PER_LAYER, PH_COUNT = PH_FINAL + 1;
template <class P, int OFF> __device__ __forceinline__ P karg_ptr() {
    unsigned long long v; auto kp = __builtin_amdgcn_kernarg_segment_ptr();
    asm volatile("s_load_dwordx2 %0, %1, %2\n\ts_waitcnt lgkmcnt(0)" : "=s"(v) : "s"(kp), "i"(OFF));
    return (P)v;
}
#define KARG(m) karg_ptr<GAS std::remove_pointer<decltype(Args::m)>::type*, offsetof(Args, m)>()
struct Idx { int tid, lane, wave, G, bx, vcu, gw, NGW, gtid, NTHR; };
__device__ __forceinline__ Idx make_idx() {
    Idx I; int t = threadIdx.x; asm volatile("" : "+v"(t));
    I.tid = t; I.lane = t & 63; I.wave = __builtin_amdgcn_readfirstlane(t >> 6); I.G = gridDim.x; I.bx = blockIdx.x;
    I.vcu = (I.G % 8 == 0) ? (I.bx % 8) * (I.G / 8) + I.bx / 8 : I.bx;
    I.gw = I.bx * NWAVES + I.wave; I.NGW = I.G * NWAVES; I.gtid = I.bx * (NWAVES * 64) + t; I.NTHR = I.G * NWAVES * 64; return I;
}

__global__ void __launch_bounds__(NWAVES * 64, 2) trunk_fwd(Args a) {
    extern __shared__ __attribute__((aligned(16))) unsigned char lds_raw[];
    LAS unsigned char* lds = (LAS unsigned char*)lds_raw;
    for (int u = threadIdx.x; u < (LDS_BYTES - LDSCTL_OFF) / 4; u += NWAVES * 64) ((LAS unsigned*)(lds + LDSCTL_OFF))[u] = 0u;
    __syncthreads();
    const int lo = a.ph_lo, hi = a.ph_hi;
    if (hi - lo > 1) (void)xcd_barrier_post((gu32*)(KARG(ws) + WS_CTL) + CW_BAR, (volatile LAS unsigned*)(lds + MISC_OFF) + 8);
#define IN(k) (lo <= (k) && (k) < hi)
#define SEAM(k) do { if ((k) + 1 < hi) { XcdBarrier bar_; bar_.bar = (gu32*)(KARG(ws) + WS_CTL) + CW_BAR; bar_.x = xb_xcc_id(); bar_.st = (volatile LAS unsigned*)(lds + MISC_OFF) + 8; xcd_barrier(bar_); } } while (0)
#define WSP(T_, off) ((GAS T_*)(KARG(ws) + (off)))

    if (IN(0)) {
        const Idx I = make_idx(); const int gw = I.gw, NGW = I.NGW, lane = I.lane;
        { gfloat* tab = WSP(float, WS_TAB); const gint* pos = KARG(pos);
          for (int i = I.gtid; i < T * 32; i += I.NTHR) { const int row = i >> 5, f = i & 31;
            const double rev = (double)pos[row] * INVF[f] * 0.15915494309189535;
            const float fr = (float)(rev - rint(rev));
            tab[2 * i] = __builtin_amdgcn_cosf(fr); tab[2 * i + 1] = __builtin_amdgcn_sinf(fr); } }
        LAS unsigned char* scr = lds + RING_OFF + I.wave * 8192;
        guchar* ws = KARG(ws);
        { const gfloat* x = KARG(x); gbf16* HB = (gbf16*)(ws + WS_XN); gu64* ssq0 = (gu64*)(ws + WS_SSQ);
          for (int row = gw; row < T; row += NGW) {
            const GAS f32x4* xr = (const GAS f32x4*)(x + (size_t)row * D) + lane; GAS v2u* o8 = (GAS v2u*)(HB + (size_t)row * D) + lane; float ss = 0.f;
#pragma unroll
            for (int jj = 0; jj < 16; ++jj) { const f32x4 v = xr[64 * jj]; ss += (v.x * v.x + v.y * v.y) + (v.z * v.z + v.w * v.w); v2u w; w.x = pk2(v.x, v.y); w.y = pk2(v.z, v.w); o8[64 * jj] = w; }
            ss = wave_sum(ss); if (lane == 0) ssq0[row] = pg8::ssq_fix(ss); } }
        const gfloat* attn_g = KARG(attn_g); const gfloat* ffn_g = KARG(ffn_g);
        for (int j = 0; j < 2; ++j) {
            transpose_cols(KARG(sc_w_in) + (size_t)j * D * 3 * D, D, 3 * D, 3 * D, RowCvb{}, attn_g + (size_t)(2 * j) * D, (gbf16*)(ws + WS_WIN + j * SZ_WIN), scr, gw, NGW, lane);
            transpose_cols(KARG(sc_w_out) + (size_t)j * D * D, D, D, D, RowPlain{0}, nullptr, (gbf16*)(ws + WS_WOUT + j * SZ_WOUT), scr, gw, NGW, lane);
            transpose_cols(KARG(wq_a) + (size_t)j * D * QLORA, D, QLORA, QLORA, RowPlain{0}, attn_g + (size_t)(2 * j + 1) * D, (gbf16*)(ws + WS_WQKVA + j * SZ_WQKVA), scr, gw, NGW, lane);
            transpose_cols(KARG(wkv_a) + (size_t)j * D * (KVLORA + ROPE), D, KVLORA + ROPE, KVLORA + ROPE, RowKva{}, attn_g + (size_t)(2 * j + 1) * D, (gbf16*)(ws + WS_WQKVA + j * SZ_WQKVA), scr, gw, NGW, lane);
            { GAS v4u* z = (GAS v4u*)(ws + WS_WQKVA + j * SZ_WQKVA + (size_t)(QLORA + KVLORA + ROPE) * D * 2);
              for (int i = I.gtid; i < (NQKVA - QLORA - KVLORA - ROPE) * D * 2 / 16; i += I.NTHR) z[i] = (v4u){0u, 0u, 0u, 0u}; }
        }
        for (int i = 0; i < 1; ++i) {
            transpose_cols(KARG(w_gate) + (size_t)i * D * DFF, D, DFF, DFF, RowGu{0}, ffn_g + (size_t)i * D, (gbf16*)(ws + WS_WGU + i * SZ_WGU), scr, gw, NGW, lane);
            transpose_cols(KARG(w_up) + (size_t)i * D * DFF, D, DFF, DFF, RowGu{1}, ffn_g + (size_t)i * D, (gbf16*)(ws + WS_WGU + i * SZ_WGU), scr, gw, NGW, lane);
        }
        SEAM(0);
    }

    for (int L = 0; L < DEPTH; ++L) {
        const int pb = 1 + L * PH_PER_LAYER, j = L >> 1;
#define SSQ(i) ((gu64*)(KARG(ws) + WS_SSQ) + (size_t)(i) * T)
        if ((L & 1) == 0) {
            if (IN(pb + 1)) {
                pg8::Gemm g = pg8::make_gemm(WSP(bf16, WS_XN), WSP(bf16, WS_WIN + j * SZ_WIN), T, 2 * D, D, D, D); pg8::StaticOrder S; S.init(T, 2 * D, gridDim.x, blockIdx.x);
                pg8::EpiCv E{WSP(bf16, WS_CVC), SSQ(2 * L), WSP(float, WS_HALO), KARG(sc_conv_w) + (size_t)j * 3 * D, (LAS float*)(lds + XCH_OFF), D};
                pg8::gemm_phase<pg8::EpiCv, pg8::StaticOrder, true, true, pg8::Row4>(lds + RING_OFF, g, S, E);
                SEAM(pb + 1);
            }
            if (IN(pb + 2)) { const Idx I = make_idx(); conv_fixup_phase(WSP(float, WS_HALO), KARG(sc_conv_w) + (size_t)j * 3 * D, WSP(bf16, WS_CVC), I.gtid, I.NTHR); SEAM(pb + 2); }
            if (IN(pb + 3)) {
                pg8::Gemm g = pg8::make_gemm(WSP(bf16, WS_XN), WSP(bf16, WS_WIN + j * SZ_WIN) + (size_t)2 * D * D, T, D, D, D, D); pg8::StaticOrder S; S.init(T, D, gridDim.x, blockIdx.x);
                pg8::EpiY E{WSP(bf16, WS_Y), WSP(bf16, WS_CVC), SSQ(2 * L), D};
                pg8::gemm_phase<pg8::EpiY, pg8::StaticOrder, true, true>(lds + RING_OFF, g, S, E);
                SEAM(pb + 3);
            }
            if (IN(pb + 4)) {
                pg8::Gemm g = pg8::make_gemm(WSP(bf16, WS_Y), WSP(bf16, WS_WOUT + j * SZ_WOUT), T, D, D, D, D); pg8::StaticOrder S; S.init(T, D, gridDim.x, blockIdx.x);
                pg8::EpiResid E{WSP(bf16, WS_XN), SSQ(2 * L + 1), D};
                pg8::gemm_phase<pg8::EpiResid, pg8::StaticOrder, true, true>(lds + RING_OFF, g, S, E);
                SEAM(pb + 4);
            }
        } else {
            if (IN(pb + 1)) {
                pg8::Gemm g = pg8::make_gemm(WSP(bf16, WS_XN), WSP(bf16, WS_WQKVA + j * SZ_WQKVA), T, NQKVA, D, D, D); pg8::StaticOrder S; S.init(T, NQKVA, gridDim.x, blockIdx.x);
                pg8::EpiQkva E{WSP(bf16, WS_QA), WSP(bf16, WS_KR), WSP(float, WS_TAB), SSQ(2 * L), SSQ(SSQ_Q + 2 * j), SSQ(SSQ_KV + 2 * j)};
                pg8::gemm_phase<pg8::EpiQkva, pg8::StaticOrder, true, true>(lds + RING_OFF, g, S, E);
                {
                    constexpr int NU = (T / 256) * (NQKVA / 256);
                    const int G_ = gridDim.x, nfull = NU % G_, nconv = (nfull == 0) ? G_ : G_ - nfull, cw0 = (nfull == 0) ? 0 : nfull;
                    if ((int)blockIdx.x >= cw0) { const Idx I = make_idx(); guchar* ws = KARG(ws); LAS unsigned char* scr = lds + RING_OFF + I.wave * 8192;
                        const int gw = ((int)blockIdx.x - cw0) * NWAVES + I.wave, NGW = nconv * NWAVES, lane = I.lane;
                        transpose_cols(KARG(wq_b) + (size_t)j * QLORA * NH * QKD, QLORA, NH * QKD, NH * QKD, RowQb{}, KARG(q_g) + (size_t)j * QLORA, (gbf16*)(ws + WS_WQB + j * SZ_WQB), scr, gw, NGW, lane);
                        transpose_cols(KARG(wkv_b) + (size_t)j * KVLORA * NH * (NOPE + VD), KVLORA, NH * (NOPE + VD), NH * (NOPE + VD), RowKvb{}, KARG(kv_g) + (size_t)j * KVLORA, (gbf16*)(ws + WS_WUK + j * SZ_WKVB), scr, gw, NGW, lane);
                        transpose_cols(KARG(wo) + (size_t)j * D * D, D, D, D, RowPlain{0}, nullptr, (gbf16*)(ws + WS_WO + j * SZ_WO), scr, gw, NGW, lane);
                    }
                }
                SEAM(pb + 1);
            }
            if (IN(pb + 3)) {
                { pg8::Gemm g = pg8::make_gemm(WSP(bf16, WS_QA), WSP(bf16, WS_WQB + j * SZ_WQB), T, NH * QKD, QLORA, QLORA + KVLORA, QLORA); pg8::StaticOrder S; S.init(T, NH * QKD, gridDim.x, blockIdx.x);
                  pg8::EpiQ E{WSP(bf16, WS_Q), NH * QKD, WSP(float, WS_TAB), QSCALE, SSQ(SSQ_Q + 2 * j), 1.0f / QLORA};
                  pg8::gemm_phase<pg8::EpiQ, pg8::StaticOrder, true, true>(lds + RING_OFF, g, S, E); }
                { pg8::Gemm g = pg8::make_gemm(WSP(bf16, WS_QA) + QLORA, WSP(bf16, WS_WUK + j * SZ_WKVB), T, NH * NOPE, KVLORA, QLORA + KVLORA, KVLORA); pg8::StaticOrder S; S.init(T, NH * NOPE, gridDim.x, blockIdx.x);
                  pg8::EpiKN E{WSP(bf16, WS_KF), WSP(bf16, WS_KR), SSQ(SSQ_KV + 2 * j), 1.0f / KVLORA};
                  pg8::gemm_phase<pg8::EpiKN, pg8::StaticOrder, true, true>(lds + RING_OFF, g, S, E); }
                { pg8::Gemm g = pg8::make_gemm(WSP(bf16, WS_WUV + j * SZ_WKVB), WSP(bf16, WS_QA) + QLORA, NH * VD, T, KVLORA, KVLORA, QLORA + KVLORA); pg8::StaticOrder S; S.init(NH * VD, T, gridDim.x, blockIdx.x);
                  pg8::EpiVT E{WSP(bf16, WS_VT), T, SSQ(SSQ_KV + 2 * j), 1.0f / KVLORA};
                  pg8::gemm_phase<pg8::EpiVT, pg8::StaticOrder, true, true>(lds + RING_OFF, g, S, E); }
                SEAM(pb + 3);
            }
            if (IN(pb + 4)) {
                const Idx I = make_idx();
                const attn::Tensors X{WSP(bf16, WS_Q), WSP(bf16, WS_KF), WSP(bf16, WS_VT), WSP(bf16, WS_O)};
                attn::phase(lds + RING_OFF, X, I.vcu, I.G, I.wave, I.lane);
                SEAM(pb + 4);
            }
            if (IN(pb + 5)) {
                pg8::Gemm g = pg8::make_gemm(WSP(bf16, WS_O), WSP(bf16, WS_WO + j * SZ_WO), T, D, D, D, D); pg8::StaticOrder S; S.init(T, D, gridDim.x, blockIdx.x);
                pg8::EpiResid E{WSP(bf16, WS_XN), SSQ(2 * L + 1), D};
                pg8::gemm_phase<pg8::EpiResid, pg8::StaticOrder, true, true>(lds + RING_OFF, g, S, E);
                SEAM(pb + 5);
            }
        }
        if (IN(pb + 7)) {
            pg8::Gemm g = pg8::make_gemm(WSP(bf16, WS_XN), WSP(bf16, WS_WGU + L * SZ_WGU), T, 2 * DFF, D, D, D); pg8::StaticOrder S; S.init(T, 2 * DFF, gridDim.x, blockIdx.x);
            const bool cvn = (L + 1 < DEPTH);
            pg8::EpiFfn E{WSP(bf16, WS_ACT), SSQ(2 * L + 1), WSP(float, WS_HALO), KARG(f_conv_w) + (size_t)L * 3 * DFF, KARG(f_conv_b) + (size_t)L * DFF, (LAS float*)(lds + XCH_OFF), DFF,
                          cvn ? KARG(w_gate) + (size_t)(L + 1) * D * DFF : nullptr, cvn ? KARG(w_up) + (size_t)(L + 1) * D * DFF : nullptr, KARG(ffn_g) + (size_t)(cvn ? L + 1 : 0) * D,
                          WSP(bf16, WS_WGU + (size_t)(cvn ? L + 1 : 0) * SZ_WGU), lds + RING_OFF + 8 * pg8::HTB};
            pg8::gemm_phase<pg8::EpiFfn, pg8::StaticOrder, true, true, pg8::Row4>(lds + RING_OFF, g, S, E);
            {
                constexpr int NMAIN = (T / 256) * (2 * DFF / 256);
                const int G_ = gridDim.x, nfull = NMAIN % G_, nconv = (nfull == 0) ? G_ : G_ - nfull, cw0 = (nfull == 0) ? 0 : nfull;
                if ((int)blockIdx.x >= cw0) { const Idx I = make_idx();
                    transpose_cols(KARG(w_down) + (size_t)L * DFF * D, DFF, D, D, RowPlain{0}, nullptr, WSP(bf16, WS_WDN + L * SZ_WDN), lds + RING_OFF + I.wave * 8192, ((int)blockIdx.x - cw0) * NWAVES + I.wave, nconv * NWAVES, I.lane); }
            }
            SEAM(pb + 7);
        }
        if (IN(pb + 8)) { const Idx I = make_idx(); ffn_fixup_phase(WSP(float, WS_HALO), KARG(f_conv_w) + (size_t)L * 3 * DFF, KARG(f_conv_b) + (size_t)L * DFF, WSP(bf16, WS_ACT), I.gtid, I.NTHR); SEAM(pb + 8); }
        if (IN(pb + 9)) {
            pg8::Gemm g = pg8::make_gemm(WSP(bf16, WS_ACT), WSP(bf16, WS_WDN + L * SZ_WDN), T, D, DFF, DFF, DFF); pg8::StaticOrder S; S.init(T, D, gridDim.x, blockIdx.x, 4);
            pg8::EpiResid E{WSP(bf16, WS_XN), SSQ(2 * L + 2), D};
            pg8::gemm_phase<pg8::EpiResid, pg8::StaticOrder, true, true>(lds + RING_OFF, g, S, E);
            SEAM(pb + 9);
        }
    }
    if (IN(PH_FINAL)) { const Idx I = make_idx(); gfloat* o = KARG(out); const gfloat* g = KARG(final_g); const gu64* sq = SSQ(8); const gbf16* hb = WSP(bf16, WS_XN);
        for (int i = I.gtid; i < T * (D / 8); i += I.NTHR) { const int row = i >> 9, c8 = i & 511;
            const float s = pg8::rstd_of(sq, row, 1.0f / D); const f32x4 g0 = *((const GAS f32x4*)g + 2 * c8), g1 = *((const GAS f32x4*)g + 2 * c8 + 1);
            float f[8]; unpack8(*((const GAS v4u*)hb + i), f);
            GAS f32x4* p = (GAS f32x4*)o + 2 * (size_t)i;
            p[0] = (f32x4){f[0], f[1], f[2], f[3]} * s * g0; p[1] = (f32x4){f[4], f[5], f[6], f[7]} * s * g1; } }
#undef IN
#undef SEAM
#undef WSP
#undef SSQ
}

static bool phase_exists(int p) {
    if (p == 0 || p == PH_FINAL) return true;
    const int L = (p - 1) / PH_PER_LAYER, s = (p - 1) % PH_PER_LAYER;
    if (s >= 7) return true;
    return (L & 1) ? (s == 1 || s == 3 || s == 4 || s == 5) : (s == 1 || s == 2 || s == 3 || s == 4);
}
extern "C" void kernel_launch(void* const* d_in, const int* in_sizes, int n_in, void* d_out, int out_size, void* d_ws, size_t ws_size, hipStream_t stream) {
    static int grid = 0;
    if (grid == 0) {
        if (n_in != 20 || in_sizes[0] != T * D || out_size != T * D || ws_size < WS_END) {
            fprintf(stderr, "kernel_launch: unexpected shapes (n_in %d, in0 %d, out %d, ws %zu, need %zu); nothing launched\n", n_in, n_in > 0 ? in_sizes[0] : -1, out_size, ws_size, (size_t)WS_END); grid = -1; return; }
        int dev = 0, cus = 0, per_cu = 0;
        if (hipGetDevice(&dev) != hipSuccess || hipDeviceGetAttribute(&cus, hipDeviceAttributeMultiprocessorCount, dev) != hipSuccess) { grid = -1; return; }
        if (hipFuncSetAttribute((const void*)trunk_fwd, hipFuncAttributeMaxDynamicSharedMemorySize, LDS_BYTES) != hipSuccess) { fprintf(stderr, "kernel_launch: hipFuncSetAttribute failed\n"); grid = -1; return; }
        if (hipOccupancyMaxActiveBlocksPerMultiprocessor(&per_cu, (const void*)trunk_fwd, NWAVES * 64, LDS_BYTES) != hipSuccess || per_cu < 1)
            fprintf(stderr, "kernel_launch: note: occupancy query reports %d workgroups per CU\n", per_cu);
        (void)hipGetLastError();
        grid = cus;
    }
    if (grid < 0) return;
    if (hipMemsetAsync((char*)d_ws + WS_CTL, 0, CTL_ZERO_BYTES, stream) != hipSuccess) { fprintf(stderr, "kernel_launch: memset failed\n"); return; }
    Args a{};
    a.x = (const float*)d_in[0]; a.pos = (const int*)d_in[1]; a.attn_g = (const float*)d_in[2]; a.ffn_g = (const float*)d_in[3]; a.final_g = (const float*)d_in[4];
    a.sc_w_in = (const float*)d_in[5]; a.sc_conv_w = (const float*)d_in[6]; a.sc_w_out = (const float*)d_in[7];
    a.wq_a = (const float*)d_in[8]; a.q_g = (const float*)d_in[9]; a.wq_b = (const float*)d_in[10]; a.wkv_a = (const float*)d_in[11]; a.kv_g = (const float*)d_in[12];
    a.wkv_b = (const float*)d_in[13]; a.wo = (const float*)d_in[14];
    a.w_gate = (const float*)d_in[15]; a.w_up = (const float*)d_in[16]; a.f_conv_w = (const float*)d_in[17]; a.f_conv_b = (const float*)d_in[18]; a.w_down = (const float*)d_in[19];
    a.out = (float*)d_out; a.ws = (unsigned char*)d_ws;
#if MK_PER_PHASE
    for (int p = 0; p < PH_COUNT; ++p) {
        if (!phase_exists(p)) continue;
        a.ph_lo = p; a.ph_hi = p + 1;
        hipLaunchKernelGGL(trunk_fwd, dim3(grid), dim3(NWAVES * 64), LDS_BYTES, stream, a);
    }
#else
    a.ph_lo = 0; a.ph_hi = PH_COUNT;
    hipLaunchKernelGGL(trunk_fwd, dim3(grid), dim3(NWAVES * 64), LDS_BYTES, stream, a);
#endif
    const hipError_t le = hipPeekAtLastError();
    if (le != hipSuccess) fprintf(stderr, "kernel_launch: launch failed: %s\n", hipGetErrorName(le));
}
```

```cpp
#include <hip/hip_runtime.h>
#include <cstdio>
#include <cstdint>

#include <type_traits>
#define GAS __attribute__((address_space(1)))
typedef GAS float gfloat; typedef GAS unsigned short gbf16; typedef GAS int gint; typedef GAS unsigned gu32; typedef GAS unsigned char guchar; typedef GAS unsigned long long gu64;
#ifndef MK_PER_PHASE
#define MK_PER_PHASE 0
#endif

namespace pg8 {
#define PG8_LAS __attribute__((address_space(3)))
typedef unsigned short bf16_t;
typedef short bf16x8 __attribute__((ext_vector_type(8)));
typedef float f32x4 __attribute__((ext_vector_type(4)));
typedef float f32x2 __attribute__((ext_vector_type(2)));
typedef unsigned u32x4 __attribute__((ext_vector_type(4)));
typedef unsigned u32x2 __attribute__((ext_vector_type(2)));
constexpr int BM = 256, BK = 64, HALF = 128, HTB = HALF * BK * 2  , STAGE_BYTES = 8 * HTB, NXCD = 8, WGM = 8;

__host__ __device__ __forceinline__ int lds_byte(int r, int c) { const int st = (r >> 4) * 2 + (c >> 5), rr = r & 15, cc = c & 31, ob = rr * 64 + cc * 2; return st * 1024 + (ob ^ (((ob >> 9) & 1) << 5)); }
__host__ __device__ __forceinline__ void stage_rc(int b, int& R, int& C) { const int st = b / 1024, sb = b % 1024, swz = sb ^ (((sb >> 9) & 1) << 5); R = (st >> 1) * 16 + swz / 64; C = (st & 1) * 32 + (swz % 64) / 2; }
__host__ __device__ __forceinline__ int perm32(int rho) { const int n = rho >> 4, i = rho & 15; return 8 * (i >> 2) + 4 * n + (i & 3); }

struct Unit { int pm, pn; };
struct Gemm { const gbf16* A; const gbf16* Bt; int M, N, K, lda, ldb;
    size_t hstepA, tstepA, hstepB, tstepB, pmstepB; };
__device__ __forceinline__ Gemm make_gemm(const gbf16* A, const gbf16* Bt, int M, int N, int K, int lda, int ldb) {
    Gemm g; g.A = A; g.Bt = Bt; g.M = M; g.N = N; g.K = K; g.lda = lda; g.ldb = ldb;
    g.hstepA = (size_t)HALF * lda * 2; g.tstepA = 2 * g.hstepA; g.hstepB = (size_t)HALF * ldb * 2; g.tstepB = 2 * g.hstepB; g.pmstepB = 0; return g; }
struct RowId { __device__ __forceinline__ int operator()(int R) const { return R; } };

struct StaticOrder {
    int nM, nN, nwg, G, c, wgm;
    __host__ __device__ void init(int M, int N, int G_, int c_, int wgm_ = WGM) { nM = M / BM; nN = N / BM; nwg = nM * nN; G = G_; c = c_; wgm = wgm_; }
    __host__ __device__ bool next(int i, Unit& u) const {
        const long L = (long)i * G + c; if (L >= nwg) return false;
        int wgid = (int)L; { const int q = nwg / NXCD, r = nwg % NXCD, xcd = wgid % NXCD, off = wgid / NXCD; wgid = (xcd < r ? xcd * (q + 1) : r * (q + 1) + (xcd - r) * q) + off; }
        const int nig = wgm * nN, gid = wgid / nig, fm = gid * wgm, gsz = (nM - fm) < wgm ? (nM - fm) : wgm;
        u.pm = fm + ((wgid % nig) % gsz); u.pn = (wgid % nig) / gsz; return true;
    }
    __device__ __forceinline__ void a_ready(const Unit&) const {}
    __device__ __forceinline__ void done(const Unit&) const {}
};

__device__ __forceinline__ unsigned cvt_pk_bf16(float lo, float hi) { unsigned r; asm volatile("v_cvt_pk_bf16_f32 %0, %1, %2" : "=v"(r) : "v"(lo), "v"(hi)); return r; }

constexpr float EPS_ = 1e-6f;
constexpr float SSQ_SCALE = 1048576.0f, SSQ_INV = 1.0f / 1048576.0f;
__device__ __forceinline__ unsigned long long ssq_fix(float sq) { return (unsigned long long)(sq * SSQ_SCALE); }
__device__ __forceinline__ void ssq_add(gu64* p, float sq) { (void)__hip_atomic_fetch_add(p, ssq_fix(sq), __ATOMIC_RELAXED, __HIP_MEMORY_SCOPE_AGENT); }
__device__ __forceinline__ float rstd_of(const gu64* ssq, int row, float invn) { const unsigned long long v = ssq[row];
    const float f = __builtin_fmaf((float)(unsigned)(v >> 32), 4294967296.0f, (float)(unsigned)v); return __builtin_amdgcn_rsqf(f * (invn * SSQ_INV) + EPS_); }
__device__ __forceinline__ float sq4(const f32x4 v) { return (v[0] * v[0] + v[1] * v[1]) + (v[2] * v[2] + v[3] * v[3]); }
__device__ __forceinline__ float quad_sum(float v) { v += __shfl_xor(v, 16); v += __shfl_xor(v, 32); return v; }
__device__ __forceinline__ u32x4 pack8(const f32x4 v0, const f32x4 v1) { u32x4 w; w.x = cvt_pk_bf16(v0[0], v0[1]); w.y = cvt_pk_bf16(v0[2], v0[3]); w.z = cvt_pk_bf16(v1[0], v1[1]); w.w = cvt_pk_bf16(v1[2], v1[3]); return w; }

struct EpiVT {
    static constexpr bool PERM = true, AFTER_DRAIN = false, NEEDS_ALIGN = false;
    gbf16* O; int ldc; const gu64* ssq; float invn;
    __device__ __forceinline__ void operator()(const f32x4 (&acc)[2][2][4][2], const Unit& u, int wr, int wc, int fr, int fq) const {
        const int row0 = u.pm * BM + wr * 64 + fr, col0 = u.pn * BM + wc * 32 + 8 * fq;
        f32x4 s0[2], s1[2];
#pragma unroll
        for (int bj = 0; bj < 2; ++bj)
#pragma unroll
            for (int e = 0; e < 4; ++e) { s0[bj][e] = rstd_of(ssq, col0 + bj * HALF + e, invn); s1[bj][e] = rstd_of(ssq, col0 + bj * HALF + 4 + e, invn); }
#pragma unroll
        for (int ai = 0; ai < 2; ++ai)
#pragma unroll
            for (int m = 0; m < 4; ++m) { gbf16* rowp = O + (size_t)(row0 + ai * HALF + m * 16) * ldc + col0;
#pragma unroll
                for (int bj = 0; bj < 2; ++bj) *(GAS u32x4*)(rowp + bj * HALF) = pack8(acc[ai][bj][m][0] * s0[bj], acc[ai][bj][m][1] * s1[bj]); }
    }
};
struct EpiResid {
    static constexpr bool PERM = true, AFTER_DRAIN = false, NEEDS_ALIGN = false;
    gbf16* HB; gu64* ssq; int ldc;
    __device__ __forceinline__ void operator()(const f32x4 (&acc)[2][2][4][2], const Unit& u, int wr, int wc, int fr, int fq) const {
        const int row0 = u.pm * BM + wr * 64 + fr, col0 = u.pn * BM + wc * 32 + 8 * fq;
        u32x4 b[2][4][2];
#pragma unroll
        for (int ai = 0; ai < 2; ++ai)
#pragma unroll
            for (int m = 0; m < 4; ++m)
#pragma unroll
                for (int bj = 0; bj < 2; ++bj) b[ai][m][bj] = *(const GAS u32x4*)(HB + (size_t)(row0 + ai * HALF + m * 16) * ldc + col0 + bj * HALF);
        asm volatile("" ::: "memory");
#pragma unroll
        for (int ai = 0; ai < 2; ++ai)
#pragma unroll
            for (int m = 0; m < 4; ++m) { const int row = row0 + ai * HALF + m * 16; const size_t off = (size_t)row * ldc + col0;
                float sq = 0.f;
#pragma unroll
                for (int bj = 0; bj < 2; ++bj) { const u32x4 bb = b[ai][m][bj];
                    const f32x4 b0 = {__uint_as_float(bb.x << 16), __uint_as_float(bb.x & 0xffff0000u), __uint_as_float(bb.y << 16), __uint_as_float(bb.y & 0xffff0000u)};
                    const f32x4 b1 = {__uint_as_float(bb.z << 16), __uint_as_float(bb.z & 0xffff0000u), __uint_as_float(bb.w << 16), __uint_as_float(bb.w & 0xffff0000u)};
                    const f32x4 o0 = acc[ai][bj][m][0] + b0, o1 = acc[ai][bj][m][1] + b1;
                    *(GAS u32x4*)(HB + off + bj * HALF) = pack8(o0, o1); sq += sq4(o0) + sq4(o1); }
                sq = quad_sum(sq);
                if (fq == 0) ssq_add(ssq + row, sq);
                asm volatile("" ::: "memory"); }
    }
};
struct Row4 { __device__ __forceinline__ int operator()(int R) const { return (R & ~63) | ((R & 15) << 2) | ((R >> 4) & 3); } };
__device__ __forceinline__ float dpp_shr1(float keep, float v) { return __int_as_float(__builtin_amdgcn_update_dpp(__float_as_int(keep), __float_as_int(v), 0x111, 0xf, 0xf, false)); }
__device__ __forceinline__ f32x4 shr1x4(const f32x4 keep, const f32x4 v) { f32x4 r;
#pragma unroll
    for (int e = 0; e < 4; ++e) r[e] = dpp_shr1(keep[e], v[e]);
    return r; }
struct EpiFfn {
    static constexpr bool PERM = true, AFTER_DRAIN = false, NEEDS_ALIGN = true;
    gbf16* ACT; const gu64* ssq; gfloat* save; const gfloat* cw; const gfloat* cb; PG8_LAS float* X; int dff;
    const gfloat* cvG; const gfloat* cvU; const gfloat* cvgain; gbf16* cvdst; PG8_LAS unsigned char* cvscr;
    __device__ __forceinline__ void operator()(const f32x4 (&acc)[2][2][4][2], const Unit& u, int wr, int wc, int fr, int fq) const {
        const int row0 = u.pm * BM + wr * 64 + 4 * fr, lc = wc * 32 + 8 * fq, f0 = u.pn * HALF + lc;
        float s[2][4];
#pragma unroll
        for (int ai = 0; ai < 2; ++ai)
#pragma unroll
            for (int m = 0; m < 4; ++m) s[ai][m] = rstd_of(ssq, row0 + ai * HALF + m, 1.0f / 4096.0f);
        if (fr == 15) {
#pragma unroll
            for (int ai = 0; ai < 2; ++ai)
#pragma unroll
                for (int n = 0; n < 2; ++n) { *(PG8_LAS f32x4*)(X + (((ai * 2 + wr) * 2 + 0) * 128 + lc + 4 * n)) = acc[ai][0][2][n] * s[ai][2];
                                              *(PG8_LAS f32x4*)(X + (((ai * 2 + wr) * 2 + 1) * 128 + lc + 4 * n)) = acc[ai][0][3][n] * s[ai][3]; }
            if (wr == 1) {
#pragma unroll
                for (int n = 0; n < 2; ++n) { *(GAS f32x4*)(save + ((size_t)(0 * 64 + u.pm) * 2 + 0) * dff + f0 + 4 * n) = acc[1][0][2][n] * s[1][2];
                                              *(GAS f32x4*)(save + ((size_t)(0 * 64 + u.pm) * 2 + 1) * dff + f0 + 4 * n) = acc[1][0][3][n] * s[1][3]; }
            }
        }
        if (wr == 0 && fr == 0) {
#pragma unroll
            for (int r = 0; r < 2; ++r)
#pragma unroll
                for (int n = 0; n < 2; ++n) { *(GAS f32x4*)(save + ((size_t)(1 * 64 + u.pm) * 2 + r) * dff + f0 + 4 * n) = acc[0][0][r][n] * s[0][r];
                                              *(GAS f32x4*)(save + ((size_t)(2 * 64 + u.pm) * 2 + r) * dff + f0 + 4 * n) = acc[0][1][r][n] * s[0][r]; }
        }
        f32x4 w0[2], w1[2], w2[2], bb[2];
#pragma unroll
        for (int n = 0; n < 2; ++n) { w0[n] = *(const GAS f32x4*)(cw + f0 + 4 * n); w1[n] = *(const GAS f32x4*)(cw + dff + f0 + 4 * n); w2[n] = *(const GAS f32x4*)(cw + 2 * dff + f0 + 4 * n); bb[n] = *(const GAS f32x4*)(cb + f0 + 4 * n); }
        const bool docv = (cvG != nullptr);
        const int wv = wr * 4 + wc, ln = fq * 16 + fr, clq = ln >> 2, clr = ln & 3;
        int cvhalf = 0, cvk0 = 0, cvn0 = 0; f32x4 cvv[8], cvg = {0.f, 0.f, 0.f, 0.f};
#pragma unroll
        for (int j = 0; j < 8; ++j) cvv[j] = (f32x4){0.f, 0.f, 0.f, 0.f};
        asm volatile("s_waitcnt lgkmcnt(0)" ::: "memory"); __builtin_amdgcn_s_barrier(); asm volatile("" ::: "memory");
#pragma unroll
        for (int ai = 0; ai < 2; ++ai) {
            if (ai == 1 && docv) {
                const int h = (u.pm * 86 + u.pn) * 8 + wv; cvhalf = (h >= 22016) ? 1 : 0; const int idx = h - cvhalf * 22016, kb = idx / 344, cb2 = idx - kb * 344; cvk0 = 64 * kb; cvn0 = 32 * cb2;
                const gfloat* src = cvG + (size_t)cvhalf * (size_t)(cvU - cvG) + (size_t)(cvk0 + 4 * clq) * dff + cvn0 + 4 * clr;
#pragma unroll
                for (int j = 0; j < 8; ++j) cvv[j] = *(const GAS f32x4*)(src + (size_t)(j & 3) * dff + 16 * (j >> 2));
                cvg = *(const GAS f32x4*)(cvgain + cvk0 + 4 * clq);
                asm volatile("" ::: "memory");
            }
            f32x4 p1[2], p2[2];
            if (ai == 0 && wr == 0) {
#pragma unroll
                for (int n = 0; n < 2; ++n) { p1[n] = (f32x4){0.f, 0.f, 0.f, 0.f}; p2[n] = (f32x4){0.f, 0.f, 0.f, 0.f}; }
            } else {
                const int as = ai + wr - 1, ws_ = wr ^ 1;
#pragma unroll
                for (int n = 0; n < 2; ++n) { p2[n] = *(const PG8_LAS f32x4*)(X + (((as * 2 + ws_) * 2 + 0) * 128 + lc + 4 * n)); p1[n] = *(const PG8_LAS f32x4*)(X + (((as * 2 + ws_) * 2 + 1) * 128 + lc + 4 * n)); }
            }
            u32x2 lo[4];
#pragma unroll
            for (int n = 0; n < 2; ++n) {
                f32x4 g[4];
#pragma unroll
                for (int m = 0; m < 4; ++m) g[m] = acc[ai][0][m][n] * s[ai][m];
                const f32x4 d3 = shr1x4(p1[n], g[3]), d2 = shr1x4(p2[n], g[2]);
#pragma unroll
                for (int m = 0; m < 4; ++m) {
                    const f32x4 up1 = (m == 0) ? d3 : g[m == 0 ? 0 : m - 1], up2 = (m == 0) ? d2 : (m == 1) ? d3 : g[m < 2 ? 0 : m - 2], uu = acc[ai][1][m][n] * s[ai][m];
                    const f32x4 cv = __builtin_elementwise_fma(w0[n], up2, __builtin_elementwise_fma(w1[n], up1, __builtin_elementwise_fma(w2[n], g[m], bb[n])));
                    const f32x4 ea = cv * -1.4426950408889634f; f32x4 sg;
#pragma unroll
                    for (int e = 0; e < 4; ++e) sg[e] = __builtin_amdgcn_rcpf(1.0f + __builtin_amdgcn_exp2f(ea[e]));
                    const f32x4 o = cv * sg * uu;
                    if (n == 0) { lo[m].x = cvt_pk_bf16(o[0], o[1]); lo[m].y = cvt_pk_bf16(o[2], o[3]); }
                    else { u32x4 w; w.x = lo[m].x; w.y = lo[m].y; w.z = cvt_pk_bf16(o[0], o[1]); w.w = cvt_pk_bf16(o[2], o[3]);
                           *(GAS u32x4*)(ACT + (size_t)(row0 + ai * HALF + m) * dff + f0) = w; }
                }
            }
        }
        if (docv) {
            PG8_LAS unsigned char* scr = cvscr + wv * 2048;
#pragma unroll
            for (int q = 0; q < 2; ++q) {
#pragma unroll
                for (int e = 0; e < 4; ++e) { u32x2 w; w.x = cvt_pk_bf16(cvv[4 * q + 0][e] * cvg[0], cvv[4 * q + 1][e] * cvg[1]); w.y = cvt_pk_bf16(cvv[4 * q + 2][e] * cvg[2], cvv[4 * q + 3][e] * cvg[3]);
                    *(PG8_LAS u32x2*)(scr + (4 * clr + e) * 128 + clq * 8) = w; }
                asm volatile("s_waitcnt lgkmcnt(0)" ::: "memory");
#pragma unroll
                for (int jj = 0; jj < 2; ++jj) { const int n = (ln >> 3) + 8 * jj, c = ln & 7, gn = cvn0 + 16 * q + n, drow = (gn >> 7) * 256 + cvhalf * 128 + (gn & 127);
                    const u32x4 v = *(const PG8_LAS u32x4*)(scr + n * 128 + c * 16);
                    *(GAS u32x4*)(cvdst + (size_t)drow * 4096 + cvk0 + 8 * c) = v; }
                asm volatile("s_waitcnt lgkmcnt(0)" ::: "memory");
            }
        }
    }
};
struct EpiCv {
    static constexpr bool PERM = true, AFTER_DRAIN = false, NEEDS_ALIGN = true;
    gbf16* CVC; const gu64* ssq; gfloat* save; const gfloat* cw; PG8_LAS float* X; int ldc;
    __device__ __forceinline__ void operator()(f32x4 (&acc)[2][2][4][2], const Unit& u, int wr, int wc, int fr, int fq) const {
        const int row0 = u.pm * BM + wr * 64 + 4 * fr, lc = wc * 32 + 8 * fq, f0 = u.pn * HALF + lc;
#pragma unroll
        for (int ai = 0; ai < 2; ++ai)
#pragma unroll
            for (int m = 0; m < 4; ++m) { const float s = rstd_of(ssq, row0 + ai * HALF + m, 1.0f / 4096.0f), s2 = s * s;
#pragma unroll
                for (int n = 0; n < 2; ++n) acc[ai][0][m][n] = acc[ai][0][m][n] * acc[ai][1][m][n] * s2; }
        if (fr == 15) {
#pragma unroll
            for (int ai = 0; ai < 2; ++ai)
#pragma unroll
                for (int n = 0; n < 2; ++n) { *(PG8_LAS f32x4*)(X + (((ai * 2 + wr) * 2 + 0) * 128 + lc + 4 * n)) = acc[ai][0][2][n];
                                              *(PG8_LAS f32x4*)(X + (((ai * 2 + wr) * 2 + 1) * 128 + lc + 4 * n)) = acc[ai][0][3][n]; }
            if (wr == 1) {
#pragma unroll
                for (int n = 0; n < 2; ++n) { *(GAS f32x4*)(save + ((size_t)(0 * 64 + u.pm) * 2 + 0) * ldc + f0 + 4 * n) = acc[1][0][2][n];
                                              *(GAS f32x4*)(save + ((size_t)(0 * 64 + u.pm) * 2 + 1) * ldc + f0 + 4 * n) = acc[1][0][3][n]; }
            }
        }
        if (wr == 0 && fr == 0) {
#pragma unroll
            for (int r = 0; r < 2; ++r)
#pragma unroll
                for (int n = 0; n < 2; ++n) *(GAS f32x4*)(save + ((size_t)(1 * 64 + u.pm) * 2 + r) * ldc + f0 + 4 * n) = acc[0][0][r][n];
        }
        f32x4 w0[2], w1[2], w2[2];
#pragma unroll
        for (int n = 0; n < 2; ++n) { w0[n] = *(const GAS f32x4*)(cw + f0 + 4 * n); w1[n] = *(const GAS f32x4*)(cw + ldc + f0 + 4 * n); w2[n] = *(const GAS f32x4*)(cw + 2 * ldc + f0 + 4 * n); }
        asm volatile("s_waitcnt lgkmcnt(0)" ::: "memory"); __builtin_amdgcn_s_barrier(); asm volatile("" ::: "memory");
#pragma unroll
        for (int ai = 0; ai < 2; ++ai) {
            f32x4 p1[2], p2[2];
            if (ai == 0 && wr == 0) {
#pragma unroll
                for (int n = 0; n < 2; ++n) { p1[n] = (f32x4){0.f, 0.f, 0.f, 0.f}; p2[n] = (f32x4){0.f, 0.f, 0.f, 0.f}; }
            } else {
                const int as = ai + wr - 1, ws_ = wr ^ 1;
#pragma unroll
                for (int n = 0; n < 2; ++n) { p2[n] = *(const PG8_LAS f32x4*)(X + (((as * 2 + ws_) * 2 + 0) * 128 + lc + 4 * n)); p1[n] = *(const PG8_LAS f32x4*)(X + (((as * 2 + ws_) * 2 + 1) * 128 + lc + 4 * n)); }
            }
            f32x4 d3[2], d2[2];
#pragma unroll
            for (int n = 0; n < 2; ++n) { d3[n] = shr1x4(p1[n], acc[ai][0][3][n]); d2[n] = shr1x4(p2[n], acc[ai][0][2][n]); }
#pragma unroll
            for (int m = 0; m < 4; ++m) {
                f32x4 o[2];
#pragma unroll
                for (int n = 0; n < 2; ++n) { const f32x4 g = acc[ai][0][m][n];
                    const f32x4 up1 = (m == 0) ? d3[n] : acc[ai][0][m == 0 ? 0 : m - 1][n], up2 = (m == 0) ? d2[n] : (m == 1) ? d3[n] : acc[ai][0][m < 2 ? 0 : m - 2][n];
                    o[n] = __builtin_elementwise_fma(w0[n], up2, __builtin_elementwise_fma(w1[n], up1, w2[n] * g)); }
                *(GAS u32x4*)(CVC + (size_t)(row0 + ai * HALF + m) * ldc + f0) = pack8(o[0], o[1]); }
        }
    }
};
struct EpiY {
    static constexpr bool PERM = true, AFTER_DRAIN = false, NEEDS_ALIGN = false;
    gbf16* Y; const gbf16* CVC; const gu64* ssq; int ldc;
    __device__ __forceinline__ void operator()(const f32x4 (&acc)[2][2][4][2], const Unit& u, int wr, int wc, int fr, int fq) const {
        const int row0 = u.pm * BM + wr * 64 + fr, col0 = u.pn * BM + wc * 32 + 8 * fq;
        u32x4 c[2][4][2]; float s[2][4];
#pragma unroll
        for (int ai = 0; ai < 2; ++ai)
#pragma unroll
            for (int m = 0; m < 4; ++m) { const int row = row0 + ai * HALF + m * 16; s[ai][m] = rstd_of(ssq, row, 1.0f / 4096.0f);
#pragma unroll
                for (int bj = 0; bj < 2; ++bj) c[ai][m][bj] = *(const GAS u32x4*)(CVC + (size_t)row * ldc + col0 + bj * HALF); }
        asm volatile("" ::: "memory");
#pragma unroll
        for (int ai = 0; ai < 2; ++ai)
#pragma unroll
            for (int m = 0; m < 4; ++m) { const int row = row0 + ai * HALF + m * 16; const size_t off = (size_t)row * ldc + col0; const float sr = s[ai][m];
#pragma unroll
                for (int bj = 0; bj < 2; ++bj) { const u32x4 cc = c[ai][m][bj];
                    const f32x4 c0 = {__uint_as_float(cc.x << 16), __uint_as_float(cc.x & 0xffff0000u), __uint_as_float(cc.y << 16), __uint_as_float(cc.y & 0xffff0000u)};
                    const f32x4 c1 = {__uint_as_float(cc.z << 16), __uint_as_float(cc.z & 0xffff0000u), __uint_as_float(cc.w << 16), __uint_as_float(cc.w & 0xffff0000u)};
                    *(GAS u32x4*)(Y + off + bj * HALF) = pack8(acc[ai][bj][m][0] * sr * c0, acc[ai][bj][m][1] * sr * c1); } }
    }
};
struct EpiQkva {
    static constexpr bool PERM = true, AFTER_DRAIN = false, NEEDS_ALIGN = false;
    gbf16* QA; gbf16* KR; const gfloat* tab; const gu64* ssq_h; gu64* ssq_q; gu64* ssq_kv;
    __device__ __forceinline__ void operator()(const f32x4 (&acc)[2][2][4][2], const Unit& u, int wr, int wc, int fr, int fq) const {
        const int row0 = u.pm * BM + wr * 64 + fr, col0 = u.pn * BM + wc * 32 + 8 * fq;
        float sv[2][4];
#pragma unroll
        for (int ai = 0; ai < 2; ++ai)
#pragma unroll
            for (int m = 0; m < 4; ++m) sv[ai][m] = rstd_of(ssq_h, row0 + ai * HALF + m * 16, 1.0f / 4096.0f);
        asm volatile("" ::: "memory");
#pragma unroll
        for (int ai = 0; ai < 2; ++ai)
#pragma unroll
            for (int m = 0; m < 4; ++m) { const int row = row0 + ai * HALF + m * 16; const float s = sv[ai][m];
#pragma unroll
                for (int bj = 0; bj < 2; ++bj) { const int c0 = col0 + bj * HALF;
                    f32x4 v0 = acc[ai][bj][m][0] * s, v1 = acc[ai][bj][m][1] * s;
                    if (c0 < 1536) {
                        *(GAS u32x4*)(QA + (size_t)row * 1536 + c0) = pack8(v0, v1);
                        const float sq = quad_sum(sq4(v0) + sq4(v1));
                        if (fq == 0) ssq_add((c0 < 1024 ? ssq_q : ssq_kv) + row, sq);
                    } else if (c0 < 1600) {
                        const int i0 = (c0 - 1536) >> 1; const f32x4 t0 = *(const GAS f32x4*)(tab + (size_t)row * 64 + 2 * i0), t1 = *(const GAS f32x4*)(tab + (size_t)row * 64 + 2 * i0 + 4);
                        f32x4 r0, r1;
                        r0[0] = v0[0] * t0[0] - v0[1] * t0[1]; r0[1] = v0[0] * t0[1] + v0[1] * t0[0]; r0[2] = v0[2] * t0[2] - v0[3] * t0[3]; r0[3] = v0[2] * t0[3] + v0[3] * t0[2];
                        r1[0] = v1[0] * t1[0] - v1[1] * t1[1]; r1[1] = v1[0] * t1[1] + v1[1] * t1[0]; r1[2] = v1[2] * t1[2] - v1[3] * t1[3]; r1[3] = v1[2] * t1[3] + v1[3] * t1[2];
                        *(GAS u32x4*)(KR + (size_t)row * 64 + (c0 - 1536)) = pack8(r0, r1);
                    } } }
    }
};
struct EpiKN {
    static constexpr bool PERM = true, AFTER_DRAIN = false, NEEDS_ALIGN = false;
    gbf16* O; const gbf16* KR; const gu64* ssq; float invn;
    __device__ __forceinline__ void operator()(const f32x4 (&acc)[2][2][4][2], const Unit& u, int wr, int wc, int fr, int fq) const {
        const int row0 = u.pm * BM + wr * 64 + fr, col0 = u.pn * BM + wc * 32 + 8 * fq;
        const int rh = 2 * u.pn + (wc >> 1), rc = ((wc & 1) * 4 + fq) * 8;
        float sv[2][4]; u32x4 krv[2][4];
#pragma unroll
        for (int ai = 0; ai < 2; ++ai)
#pragma unroll
            for (int m = 0; m < 4; ++m) { const int row = row0 + ai * HALF + m * 16; sv[ai][m] = rstd_of(ssq, row, invn); krv[ai][m] = *(const GAS u32x4*)(KR + (size_t)row * 64 + rc); }
        asm volatile("" ::: "memory");
#pragma unroll
        for (int ai = 0; ai < 2; ++ai)
#pragma unroll
            for (int m = 0; m < 4; ++m) { const int row = row0 + ai * HALF + m * 16; gbf16* rowp = O + (size_t)row * (32 * 192);
                const float s = sv[ai][m];
                const u32x4 kr = krv[ai][m];
#pragma unroll
                for (int bj = 0; bj < 2; ++bj) { const int c = col0 + bj * HALF; *(GAS u32x4*)(rowp + (c >> 7) * 192 + (c & 127)) = pack8(acc[ai][bj][m][0] * s, acc[ai][bj][m][1] * s); }
                *(GAS u32x4*)(rowp + rh * 192 + 128 + rc) = kr; }
    }
};
struct EpiQ {
    static constexpr bool PERM = true, AFTER_DRAIN = false, NEEDS_ALIGN = false;
    gbf16* O; int ldc; const gfloat* tab; float sc; const gu64* ssq; float invn;
    __device__ __forceinline__ void operator()(const f32x4 (&acc)[2][2][4][2], const Unit& u, int wr, int wc, int fr, int fq) const {
        const int row0 = u.pm * BM + wr * 64 + fr, col0 = u.pn * BM + wc * 32 + 8 * fq;
        float sv[2][4];
#pragma unroll
        for (int ai = 0; ai < 2; ++ai)
#pragma unroll
            for (int m = 0; m < 4; ++m) sv[ai][m] = sc * rstd_of(ssq, row0 + ai * HALF + m * 16, invn);
        asm volatile("" ::: "memory");
#pragma unroll
        for (int bj = 0; bj < 2; ++bj) {
            const int c0 = col0 + bj * HALF, rem = c0 % 192; const bool rope = rem >= 128; const int i0 = rope ? (rem - 128) >> 1 : 0;
            if (rope) {
#pragma unroll
                for (int ai = 0; ai < 2; ++ai) {
                    f32x4 t0[4], t1[4];
#pragma unroll
                    for (int m = 0; m < 4; ++m) { const int row = row0 + ai * HALF + m * 16;
                        t0[m] = *(const GAS f32x4*)(tab + (size_t)row * 64 + 2 * i0); t1[m] = *(const GAS f32x4*)(tab + (size_t)row * 64 + 2 * i0 + 4); }
                    asm volatile("" ::: "memory");
#pragma unroll
                    for (int m = 0; m < 4; ++m) { const int row = row0 + ai * HALF + m * 16; const float s = sv[ai][m];
                        const f32x4 v0 = acc[ai][bj][m][0], v1 = acc[ai][bj][m][1], a0 = t0[m], a1 = t1[m];
                        f32x4 r0, r1;
                        r0[0] = v0[0] * a0[0] - v0[1] * a0[1]; r0[1] = v0[0] * a0[1] + v0[1] * a0[0];
                        r0[2] = v0[2] * a0[2] - v0[3] * a0[3]; r0[3] = v0[2] * a0[3] + v0[3] * a0[2];
                        r1[0] = v1[0] * a1[0] - v1[1] * a1[1]; r1[1] = v1[0] * a1[1] + v1[1] * a1[0];
                        r1[2] = v1[2] * a1[2] - v1[3] * a1[3]; r1[3] = v1[2] * a1[3] + v1[3] * a1[2];
                        *(GAS u32x4*)(O + (size_t)row * ldc + c0) = pack8(r0 * s, r1 * s); }
                    asm volatile("" ::: "memory"); }
            } else {
#pragma unroll
                for (int ai = 0; ai < 2; ++ai)
#pragma unroll
                    for (int m = 0; m < 4; ++m) { const int row = row0 + ai * HALF + m * 16; const float s = sv[ai][m];
                        *(GAS u32x4*)(O + (size_t)row * ldc + c0) = pack8(acc[ai][bj][m][0] * s, acc[ai][bj][m][1] * s); }
            }
        }
    }
};

template <class Epi, class Sched, bool ALIGN_EPI = false, bool SP2 = false, class AMap = RowId>
__device__ __forceinline__ void gemm_phase(PG8_LAS unsigned char* lds, const Gemm g, const Sched& S, const Epi& E) {
    int tid_ = threadIdx.x; asm volatile("" : "+v"(tid_));
    const int tid = tid_, wid = __builtin_amdgcn_readfirstlane(tid >> 6), lane = tid & 63, wr = wid >> 2, wc = wid & 3, fr = lane & 15, fq = lane >> 4;
    const int K = g.K, nt = K / BK;
    unsigned voffA[2], voffB[2];
#pragma unroll
    for (int i = 0; i < 2; ++i) { int R, C; stage_rc(tid * 16 + i * 8192, R, C); const int Rb = Epi::PERM ? ((R & ~31) + perm32(R & 31)) : R;
        voffA[i] = (unsigned)(AMap()(R) * g.lda + C) * 2u; voffB[i] = (unsigned)(Rb * g.ldb + C) * 2u; }
    const size_t kstep = (size_t)(BK * 2);
    const size_t hstepA = g.hstepA, hstepB = g.hstepB, tstepA = g.tstepA, tstepB = g.tstepB;
    static_assert(ALIGN_EPI || !Epi::NEEDS_ALIGN, "this epilogue has a workgroup barrier: both halves must run it together");
    const unsigned ldsw = (unsigned)wid * 1024u;
    const int aoff = lds_byte(wr * 64 + fr, fq * 8), boff = lds_byte(wc * 32 + fr, fq * 8);
#define PG8_SA(b, h) (((b) * 2 + (h)) * HTB)
#define PG8_SB(b, h) ((4 + (b) * 2 + (h)) * HTB)
    const unsigned lds_u = (unsigned)(__UINTPTR_TYPE__)lds;
#define PG8_STAGE(bufoff, gbase, voff) do { _Pragma("unroll") for (int _i = 0; _i < 2; ++_i) \
        asm volatile("s_mov_b32 m0, %1\n\ts_nop 0\n\tglobal_load_lds_dwordx4 %0, %2" :: "v"((voff)[_i]), "s"(lds_u + (unsigned)(bufoff) + ldsw + _i * 8192u), "s"(gbase) : "memory"); } while (0)
#define PG8_LDA(dst, b, h) do { _Pragma("unroll") for (int m = 0; m < 4; ++m) _Pragma("unroll") for (int k = 0; k < 2; ++k) dst[m][k] = *(const PG8_LAS bf16x8*)(lds + PG8_SA(b, h) + aoff + m * 2048 + k * 1024); } while (0)
#define PG8_LDB(dst, b, h) do { _Pragma("unroll") for (int n = 0; n < 2; ++n) _Pragma("unroll") for (int k = 0; k < 2; ++k) dst[n][k] = *(const PG8_LAS bf16x8*)(lds + PG8_SB(b, h) + boff + n * 2048 + k * 1024); } while (0)
#define PG8_MMA(ai, bj, At, Bt) do { __builtin_amdgcn_s_setprio(1); _Pragma("unroll") for (int m = 0; m < 4; ++m) _Pragma("unroll") for (int n = 0; n < 2; ++n) _Pragma("unroll") for (int k = 0; k < 2; ++k) \
        acc[ai][bj][m][n] = __builtin_amdgcn_mfma_f32_16x16x32_bf16(Bt[n][k], At[m][k], acc[ai][bj][m][n], 0, 0, 0); __builtin_amdgcn_s_setprio(0); } while (0)
#define PG8_WAIT_V(n) asm volatile("s_waitcnt vmcnt(" #n ")" ::: "memory")
#define PG8_WAIT_L(n) asm volatile("s_waitcnt lgkmcnt(" #n ")" ::: "memory")
#define PG8_BAR __builtin_amdgcn_s_barrier()
#define PG8_SCHED __builtin_amdgcn_sched_barrier(0)
    Unit cur, nxt; int ui = 0;
    if (!S.next(0, cur)) return;
    f32x4 acc[2][2][4][2];
#pragma unroll
    for (int a = 0; a < 2; ++a)
#pragma unroll
        for (int b = 0; b < 2; ++b)
#pragma unroll
            for (int m = 0; m < 4; ++m)
#pragma unroll
                for (int n = 0; n < 2; ++n) acc[a][b][m][n] = (f32x4){0.f, 0.f, 0.f, 0.f};
    bf16x8 At[4][2], B0[2][2], B1[2][2];
    const GAS char* cA = (const GAS char*)g.A + (size_t)cur.pm * tstepA; const GAS char* cB = (const GAS char*)g.Bt + (size_t)cur.pn * tstepB + (size_t)cur.pm * g.pmstepB;
    S.a_ready(cur);
    if constexpr (SP2) {
        PG8_STAGE(PG8_SB(0, 0), cB, voffB); PG8_STAGE(PG8_SB(0, 1), cB + hstepB, voffB); PG8_STAGE(PG8_SA(0, 0), cA, voffA); PG8_STAGE(PG8_SA(0, 1), cA + hstepA, voffA);
        if (wr == 1) PG8_BAR;
        PG8_WAIT_V(2); PG8_BAR;
        PG8_STAGE(PG8_SB(1, 0), cB + kstep, voffB); PG8_STAGE(PG8_SA(1, 0), cA + kstep, voffA); PG8_STAGE(PG8_SB(1, 1), cB + hstepB + kstep, voffB);
        PG8_WAIT_V(6); PG8_BAR;
    } else {
        PG8_STAGE(PG8_SB(0, 0), cB, voffB); PG8_STAGE(PG8_SA(0, 0), cA, voffA); PG8_STAGE(PG8_SB(0, 1), cB + hstepB, voffB); PG8_STAGE(PG8_SA(0, 1), cA + hstepA, voffA);
        if (wr == 1) PG8_BAR;
        PG8_WAIT_V(4); PG8_BAR;
        PG8_STAGE(PG8_SB(1, 0), cB + kstep, voffB); PG8_STAGE(PG8_SA(1, 0), cA + kstep, voffA); PG8_STAGE(PG8_SB(1, 1), cB + hstepB + kstep, voffB);
        PG8_WAIT_V(6); PG8_BAR;
    }
    for (;;) {
        const bool has_next = S.next(ui + 1, nxt);
        const GAS char* nA = has_next ? (const GAS char*)g.A + (size_t)nxt.pm * tstepA : cA; const GAS char* nB = has_next ? (const GAS char*)g.Bt + (size_t)nxt.pn * tstepB + (size_t)nxt.pm * g.pmstepB : cB;
        for (int t = 0; t < nt; t += 2) {
            const bool last = (t == nt - 2);
            const GAS char* a1 = cA + (size_t)(t + 1) * kstep;
            const GAS char* a2 = last ? nA : cA + (size_t)(t + 2) * kstep; const GAS char* b2 = last ? nB : cB + (size_t)(t + 2) * kstep;
            const GAS char* a3 = a2 + kstep; const GAS char* b3 = b2 + kstep;
            if (last && has_next) S.a_ready(nxt);
            if constexpr (SP2) {
            PG8_LDB(B0, 0, 0); PG8_LDB(B1, 0, 1); PG8_SCHED; PG8_LDA(At, 0, 0); PG8_STAGE(PG8_SA(1, 1), a1 + hstepA, voffA);
            PG8_WAIT_V(8); PG8_WAIT_L(0); PG8_BAR; PG8_MMA(0, 0, At, B0); PG8_MMA(0, 1, At, B1); PG8_BAR; PG8_SCHED;
            PG8_LDA(At, 0, 1); PG8_STAGE(PG8_SB(0, 0), b2, voffB); PG8_STAGE(PG8_SB(0, 1), b2 + hstepB, voffB); PG8_STAGE(PG8_SA(0, 0), a2, voffA);
            PG8_WAIT_V(8); PG8_WAIT_L(0); PG8_BAR; PG8_MMA(1, 0, At, B0); PG8_MMA(1, 1, At, B1); PG8_BAR; PG8_SCHED;
            PG8_LDB(B0, 1, 0); PG8_LDB(B1, 1, 1); PG8_SCHED; PG8_LDA(At, 1, 0); PG8_STAGE(PG8_SA(0, 1), a2 + hstepA, voffA);
            PG8_WAIT_V(8); PG8_WAIT_L(0); PG8_BAR; PG8_MMA(0, 0, At, B0); PG8_MMA(0, 1, At, B1); PG8_BAR; PG8_SCHED;
            PG8_LDA(At, 1, 1); PG8_STAGE(PG8_SB(1, 0), b3, voffB); PG8_STAGE(PG8_SB(1, 1), b3 + hstepB, voffB); PG8_STAGE(PG8_SA(1, 0), a3, voffA);
            PG8_WAIT_V(8); PG8_WAIT_L(0); PG8_BAR; PG8_MMA(1, 0, At, B0); PG8_MMA(1, 1, At, B1); PG8_BAR; PG8_SCHED;
            } else {
            PG8_LDB(B0, 0, 0); PG8_SCHED; PG8_LDA(At, 0, 0); PG8_STAGE(PG8_SA(1, 1), a1 + hstepA, voffA);
            PG8_WAIT_L(8); PG8_BAR; PG8_WAIT_L(0); PG8_MMA(0, 0, At, B0); PG8_BAR; PG8_SCHED;
            PG8_LDB(B1, 0, 1); PG8_STAGE(PG8_SB(0, 0), b2, voffB);
            PG8_BAR; PG8_WAIT_L(0); PG8_MMA(0, 1, At, B1); PG8_BAR;
            PG8_LDA(At, 0, 1); PG8_STAGE(PG8_SA(0, 0), a2, voffA);
            PG8_BAR; PG8_WAIT_L(0); PG8_MMA(1, 0, At, B0); PG8_BAR; PG8_SCHED;
            PG8_STAGE(PG8_SB(0, 1), b2 + hstepB, voffB);
            PG8_WAIT_V(6); PG8_BAR; PG8_MMA(1, 1, At, B1); PG8_BAR;
            PG8_LDB(B0, 1, 0); PG8_SCHED; PG8_LDA(At, 1, 0); PG8_STAGE(PG8_SA(0, 1), a2 + hstepA, voffA);
            PG8_WAIT_L(8); PG8_BAR; PG8_WAIT_L(0); PG8_MMA(0, 0, At, B0); PG8_BAR; PG8_SCHED;
            PG8_LDB(B1, 1, 1); PG8_STAGE(PG8_SB(1, 0), b3, voffB);
            PG8_BAR; PG8_WAIT_L(0); PG8_MMA(0, 1, At, B1); PG8_BAR;
            PG8_LDA(At, 1, 1); PG8_STAGE(PG8_SA(1, 0), a3, voffA);
            PG8_BAR; PG8_WAIT_L(0); PG8_MMA(1, 0, At, B0); PG8_BAR; PG8_SCHED;
            PG8_STAGE(PG8_SB(1, 1), b3 + hstepB, voffB);
            PG8_WAIT_V(6); PG8_BAR; PG8_MMA(1, 1, At, B1); PG8_BAR;
            }
        }
        if constexpr (ALIGN_EPI) { if (wr == 0) PG8_BAR; }
        E(acc, cur, wr, wc, fr, fq); S.done(cur);
        if (!has_next) break;
#pragma unroll
        for (int a = 0; a < 2; ++a)
#pragma unroll
            for (int b = 0; b < 2; ++b)
#pragma unroll
                for (int m = 0; m < 4; ++m)
#pragma unroll
                    for (int n = 0; n < 2; ++n) acc[a][b][m][n] = (f32x4){0.f, 0.f, 0.f, 0.f};
        cur = nxt; cA = nA; cB = nB; ++ui;
        if constexpr (ALIGN_EPI) { if (wr == 1) PG8_BAR; }
    }
    PG8_WAIT_V(0);
    if constexpr (!ALIGN_EPI) { if (wr == 0) PG8_BAR; }
    PG8_BAR;
#undef PG8_SA
#undef PG8_SB
#undef PG8_STAGE
#undef PG8_LDA
#undef PG8_LDB
#undef PG8_MMA
#undef PG8_WAIT_V
#undef PG8_WAIT_L
#undef PG8_BAR
#undef PG8_SCHED
}
}

constexpr int NWAVES = 8;
constexpr int D = 4096, BATCH = 4, SEQ = 4096, DEPTH = 4, T = BATCH * SEQ;
constexpr int DFF = 11008, NH = 32, QLORA = 1024, KVLORA = 512, NOPE = 128, ROPE = 64, QKD = 192, VD = 128;
constexpr int NQKVA = 1792;
constexpr float NORM_EPS = 1e-6f;
constexpr float QSCALE = 0.07216878364870322f * 1.4426950408889634f;

constexpr size_t MiB = 1u << 20;
constexpr size_t WS_CTL = 0, CTL_ZERO_BYTES = 2 * MiB;
constexpr size_t WS_TAB = 2 * MiB;
constexpr size_t WS_W = 8 * MiB;
constexpr size_t SZ_WIN = (size_t)3 * D * D * 2, SZ_WOUT = (size_t)D * D * 2, SZ_WQKVA = (size_t)NQKVA * D * 2, SZ_WQB = (size_t)NH * QKD * QLORA * 2,
                 SZ_WUK = (size_t)NH * NOPE * KVLORA * 2, SZ_WUV = (size_t)NH * VD * KVLORA * 2, SZ_WO = (size_t)D * D * 2, SZ_WGU = (size_t)2 * DFF * D * 2, SZ_WDN = (size_t)D * DFF * 2;
constexpr size_t SZ_WKVB = SZ_WUK + SZ_WUV;
constexpr size_t WS_WIN = WS_W, WS_WOUT = WS_WIN + 2 * SZ_WIN, WS_WQKVA = WS_WOUT + 2 * SZ_WOUT, WS_WQB = WS_WQKVA + 2 * SZ_WQKVA, WS_WUK = WS_WQB + 2 * SZ_WQB,
                 WS_WUV = WS_WUK + SZ_WUK, WS_WO = WS_WUK + 2 * SZ_WKVB, WS_WGU = WS_WO + 2 * SZ_WO, WS_WDN = WS_WGU + 4 * SZ_WGU, WS_WEND = WS_WDN + 4 * SZ_WDN;
constexpr size_t WS_XN = WS_WEND;
constexpr size_t WS_BIG = WS_XN + (size_t)T * D * 2;
constexpr size_t WS_GU = WS_BIG;
constexpr size_t WS_ACT = WS_GU + (size_t)T * 2 * DFF * 2;
constexpr size_t WS_HALO = WS_ACT + (size_t)T * DFF * 2;
constexpr size_t WS_END = WS_HALO + (size_t)4 * 64 * 2 * DFF * 4;
constexpr size_t WS_CVC = WS_BIG;
constexpr size_t WS_Y = WS_CVC + (size_t)T * D * 2;
static_assert(WS_Y + (size_t)T * D * 2 <= WS_END, "conv overlay");
constexpr size_t WS_QA = WS_BIG;
constexpr size_t WS_KR = WS_QA + (size_t)T * 1536 * 2;
constexpr size_t WS_Q = WS_KR + (size_t)T * ROPE * 2;
constexpr size_t WS_KF = WS_Q + (size_t)T * NH * QKD * 2;
constexpr size_t WS_VT = WS_KF + (size_t)T * NH * QKD * 2;
constexpr size_t WS_O = WS_VT + (size_t)T * NH * VD * 2;
static_assert(WS_O + (size_t)T * D * 2 <= WS_END, "mla overlay");
constexpr size_t WS_SSQ = 65536;
constexpr int SSQ_Q = 9, SSQ_KV = 10;
static_assert(WS_SSQ + 13 * (size_t)T * 8 <= CTL_ZERO_BYTES && WS_TAB + (size_t)T * 64 * 4 <= WS_W, "ssq arrays inside the memset region");
constexpr int CW_TMO = 0, CW_CODE = 1, CW_BAR = 4096;

constexpr int RING_OFF = 0, RING_BYTES = 147456;
constexpr int LDSCTL_OFF = RING_BYTES, MISC_OFF = LDSCTL_OFF + 320, XCH_OFF = LDSCTL_OFF + 1024;
constexpr int LDS_BYTES = 153600;
static_assert(MISC_OFF + 128 <= LDS_BYTES, "LDS map");

#define LAS __attribute__((address_space(3)))
typedef unsigned short bf16;
typedef unsigned v4u __attribute__((ext_vector_type(4)));
typedef unsigned v2u __attribute__((ext_vector_type(2)));
typedef float f32x4 __attribute__((ext_vector_type(4)));
typedef float f32x2 __attribute__((ext_vector_type(2)));
typedef float f32x16 __attribute__((ext_vector_type(16)));
typedef short bf16x8 __attribute__((ext_vector_type(8)));
#define RLX_AGENT __ATOMIC_RELAXED, __HIP_MEMORY_SCOPE_AGENT
#define LDS_WAIT() asm volatile("s_waitcnt lgkmcnt(0)" ::: "memory")
#define VM_WAIT() asm volatile("s_waitcnt vmcnt(0)" ::: "memory")
__device__ __forceinline__ unsigned pk2(float lo, float hi) { return pg8::cvt_pk_bf16(lo, hi); }
__device__ __forceinline__ float bflo(unsigned w) { return __uint_as_float(w << 16); }
__device__ __forceinline__ float bfhi(unsigned w) { return __uint_as_float(w & 0xffff0000u); }

#define XB_TMO      128
#define XB_XCNT(j)  (256  + 64 * (j))
#define XB_XSUB(j)  (1280 + 64 * (j))
#define XB_XGEN(j)  (2304 + 64 * (j))
#define XB_TOP      3328
#define XB_TOPGEN   3392
#define XCD_BAR_WORDS 3456
#define XB_SPIN_CAP (1u << 18)
__device__ __forceinline__ unsigned xb_ld(gu32* p)              { return __hip_atomic_load(p, __ATOMIC_RELAXED, __HIP_MEMORY_SCOPE_AGENT); }
__device__ __forceinline__ unsigned xb_add(gu32* p, unsigned v) { return __hip_atomic_fetch_add(p, v, __ATOMIC_RELAXED, __HIP_MEMORY_SCOPE_AGENT); }
__device__ __forceinline__ unsigned xb_xcc_id() { return (unsigned)__builtin_amdgcn_s_getreg((3 << 11) | 20) & 0xFu; }
#define XB_SPIN(cond, bar) do { unsigned _sp = 0; while (cond) { __builtin_amdgcn_s_sleep(1); \
    if ((++_sp & 255u) == 0u) { if (xb_ld(&(bar)[XB_TMO])) break; if (_sp > XB_SPIN_CAP) { (void)xb_add(&(bar)[XB_TMO], 1u); break; } } } } while (0)
struct XcdBarrier { gu32* bar; unsigned x; volatile LAS unsigned* st; };
__device__ __forceinline__ XcdBarrier xcd_barrier_post(gu32* bar, volatile LAS unsigned* st) {
    XcdBarrier b; b.bar = bar; b.x = xb_xcc_id(); b.st = st;
    if (threadIdx.x == 0) (void)xb_add(&bar[XB_XCNT(b.x)], 1u);
    return b;
}
__device__ __forceinline__ void xcd_barrier_complete(gu32* bar, unsigned x, unsigned& nloc, unsigned& nx) {
    const unsigned G = gridDim.x * gridDim.y * gridDim.z;
    unsigned sum, cnt, mine, sp = 0u;
    for (;;) {
        sum = 0u; cnt = 0u; mine = 0u;
#pragma unroll
        for (unsigned j = 0; j < 16; ++j) { const unsigned c = xb_ld(&bar[XB_XCNT(j)]); sum += c; cnt += (c > 0u) ? 1u : 0u; mine = (j == x) ? c : mine; }
        if (sum == G) break;
        __builtin_amdgcn_s_sleep(1);
        if ((++sp & 255u) == 0u) { if (xb_ld(&bar[XB_TMO])) break; if (sp > XB_SPIN_CAP) { (void)xb_add(&bar[XB_TMO], 1u); break; } }
    }
    nloc = mine > 0u ? mine : 1u; nx = cnt > 0u ? cnt : 1u;
}
__device__ __forceinline__ void xcd_barrier(const XcdBarrier& b) {
    asm volatile("s_waitcnt vmcnt(0)" ::: "memory");
    __syncthreads();
    if (threadIdx.x == 0) {
        gu32* bar = b.bar;
        __builtin_amdgcn_s_waitcnt(0);
        unsigned nloc = b.st[0], nx = b.st[1];
        if (nloc == 0u) { xcd_barrier_complete(bar, b.x, nloc, nx); b.st[0] = nloc; b.st[1] = nx; }
        const unsigned old = xb_add(&bar[XB_XSUB(b.x)], 1u);
        const unsigned gen = old / nloc;
        if (old + 1u == (gen + 1u) * nloc) {
            __builtin_amdgcn_fence(__ATOMIC_RELEASE, "agent");
            asm volatile("s_waitcnt vmcnt(0)" ::: "memory");
            const unsigned og = xb_add(&bar[XB_TOP], 1u);
            const unsigned tg = og / nx;
            if (og + 1u == (tg + 1u) * nx) xb_add(&bar[XB_TOPGEN], 1u);
            else XB_SPIN(xb_ld(&bar[XB_TOPGEN]) == tg, bar);
            __builtin_amdgcn_fence(__ATOMIC_ACQUIRE, "agent");
            xb_add(&bar[XB_XGEN(b.x)], 1u);
            asm volatile("s_waitcnt vmcnt(0)" ::: "memory");
        } else {
            XB_SPIN(xb_ld(&bar[XB_XGEN(b.x)]) == gen, bar);
            __builtin_amdgcn_fence(__ATOMIC_ACQUIRE, "agent");
            asm volatile("s_waitcnt vmcnt(0)" ::: "memory");
        }
    }
    __syncthreads();
}

__device__ __forceinline__ float wave_sum(float v) {
#pragma unroll
    for (int o = 1; o < 64; o <<= 1) v += __shfl_xor(v, o);
    return v;
}

struct RowPlain { int off; __device__ __forceinline__ int operator()(int n) const { return n + off; } };
struct RowKva { __device__ __forceinline__ int operator()(int n) const { if (n < KVLORA) return QLORA + n; const int i = n - KVLORA; return QLORA + KVLORA + 2 * (i & 31) + (i >> 5); } };
struct RowQb { __device__ __forceinline__ int operator()(int n) const { const int hh = n / QKD, r = n % QKD; if (r < NOPE) return n; const int i = r - NOPE; return hh * QKD + NOPE + 2 * (i & 31) + (i >> 5); } };
struct RowKvb { __device__ __forceinline__ int operator()(int n) const { const int hh = n >> 8, r = n & 255; return (r >> 7) * (NH * NOPE) + hh * 128 + (r & 127); } };
struct RowCvb { __device__ __forceinline__ int operator()(int n) const { if (n < 4096) return 8192 + n; const int j = (n - 4096) & 4095, v = (n - 4096) >> 12; return (j >> 7) * 256 + v * 128 + (j & 127); } };
struct RowCvbOff { int off; __device__ __forceinline__ int operator()(int n) const { return RowCvb{}(n + off); } };
struct RowGu { int half; __device__ __forceinline__ int operator()(int n) const { return (n >> 7) * 256 + half * 128 + (n & 127); } };
template <class RowFn>
__device__ __forceinline__ void transpose_cols(const gfloat* W, int K, int ld, int ncols, const RowFn rowfn, const gfloat* gain, gbf16* WT, LAS unsigned char* scr, int gw, int NGW, int lane) {
    const int ncb = ncols / 64, items = (K / 64) * ncb, lq = lane >> 4, lr = lane & 15;
    for (int it = gw; it < items; it += NGW) {
        const int kb = it / ncb, cb = it - kb * ncb, k0 = 64 * kb, n0 = 64 * cb;
        const gfloat* src = W + (size_t)(k0 + 16 * lq) * ld + n0 + 4 * lr;
        f32x4 v[16];
#pragma unroll
        for (int i = 0; i < 16; ++i) v[i] = *(const GAS f32x4*)(src + (size_t)i * ld);
        if (gain) {
#pragma unroll
            for (int i4 = 0; i4 < 4; ++i4) { const f32x4 g = *(const GAS f32x4*)(gain + k0 + 16 * lq + 4 * i4);
                v[4 * i4 + 0] = v[4 * i4 + 0] * g.x; v[4 * i4 + 1] = v[4 * i4 + 1] * g.y; v[4 * i4 + 2] = v[4 * i4 + 2] * g.z; v[4 * i4 + 3] = v[4 * i4 + 3] * g.w; }
        }
#pragma unroll
        for (int e = 0; e < 4; ++e) {
            v4u a, b;
            a.x = pk2(v[0][e], v[1][e]); a.y = pk2(v[2][e], v[3][e]); a.z = pk2(v[4][e], v[5][e]); a.w = pk2(v[6][e], v[7][e]);
            b.x = pk2(v[8][e], v[9][e]); b.y = pk2(v[10][e], v[11][e]); b.z = pk2(v[12][e], v[13][e]); b.w = pk2(v[14][e], v[15][e]);
            LAS unsigned char* rowp = scr + (4 * lr + e) * 128;
            *(LAS v4u*)(rowp + (((2 * lq) ^ (lr & 7)) << 4)) = a; *(LAS v4u*)(rowp + (((2 * lq + 1) ^ (lr & 7)) << 4)) = b;
        }
        LDS_WAIT(); asm volatile("" ::: "memory");
        const int c = lane & 7;
#pragma unroll
        for (int j = 0; j < 8; ++j) { const int n = (lane >> 3) + 8 * j;
            const v4u o = *(const LAS v4u*)(scr + n * 128 + ((c ^ ((n >> 2) & 7)) << 4));
            *(GAS v4u*)(WT + (size_t)rowfn(n0 + n) * K + k0 + 8 * c) = o; }
        LDS_WAIT(); asm volatile("" ::: "memory");
    }
}

template <class RowFn>
__device__ __forceinline__ void transpose_cols_pipe(const gfloat* W, int K, int ld, int ncols, const RowFn rowfn, const gfloat* gain, gbf16* WT, LAS unsigned char* scr, int gw, int NGW, int lane) {
    const int ncb = ncols / 64, items = (K / 64) * ncb, lq = lane >> 4, lr = lane & 15;
    f32x4 va[16], vb[16], ga[4], gb[4];
#pragma unroll
    for (int i = 0; i < 4; ++i) { ga[i] = (f32x4){1.f, 1.f, 1.f, 1.f}; gb[i] = (f32x4){1.f, 1.f, 1.f, 1.f}; }
#define TC_LOAD(v_, g_, it_) do { const int kb_ = (it_) / ncb, cb_ = (it_) - kb_ * ncb; const gfloat* src_ = W + (size_t)(64 * kb_ + 16 * lq) * ld + 64 * cb_ + 4 * lr; \
        _Pragma("unroll") for (int i = 0; i < 16; ++i) v_[i] = *(const GAS f32x4*)(src_ + (size_t)i * ld); \
        if (gain) { _Pragma("unroll") for (int i4 = 0; i4 < 4; ++i4) g_[i4] = *(const GAS f32x4*)(gain + 64 * kb_ + 16 * lq + 4 * i4); } \
        asm volatile("" ::: "memory"); } while (0)
#define TC_PROC(v_, g_, it_) do { const int kb = (it_) / ncb, cb = (it_) - kb * ncb, k0 = 64 * kb, n0 = 64 * cb; \
        if (gain) { _Pragma("unroll") for (int i4 = 0; i4 < 4; ++i4) { const f32x4 g = g_[i4]; \
                v_[4 * i4 + 0] = v_[4 * i4 + 0] * g.x; v_[4 * i4 + 1] = v_[4 * i4 + 1] * g.y; v_[4 * i4 + 2] = v_[4 * i4 + 2] * g.z; v_[4 * i4 + 3] = v_[4 * i4 + 3] * g.w; } } \
        _Pragma("unroll") for (int e = 0; e < 4; ++e) {     \
            v4u a, b; \
            a.x = pk2(v_[0][e], v_[1][e]); a.y = pk2(v_[2][e], v_[3][e]); a.z = pk2(v_[4][e], v_[5][e]); a.w = pk2(v_[6][e], v_[7][e]); \
            b.x = pk2(v_[8][e], v_[9][e]); b.y = pk2(v_[10][e], v_[11][e]); b.z = pk2(v_[12][e], v_[13][e]); b.w = pk2(v_[14][e], v_[15][e]); \
            LAS unsigned char* rowp = scr + (4 * lr + e) * 128; \
            *(LAS v4u*)(rowp + (((2 * lq) ^ (lr & 7)) << 4)) = a; *(LAS v4u*)(rowp + (((2 * lq + 1) ^ (lr & 7)) << 4)) = b; } \
        LDS_WAIT(); asm volatile("" ::: "memory"); \
        { const int c = lane & 7; \
          _Pragma("unroll") for (int j = 0; j < 8; ++j) { const int n = (lane >> 3) + 8 * j; \
            const v4u o = *(const LAS v4u*)(scr + n * 128 + ((c ^ ((n >> 2) & 7)) << 4)); \
            *(GAS v4u*)(WT + (size_t)rowfn(n0 + n) * K + k0 + 8 * c) = o; } } \
        LDS_WAIT(); asm volatile("" ::: "memory"); } while (0)
    int it = gw;
    if (it < items) TC_LOAD(va, ga, it);
    for (;;) {
        if (it >= items) break;
        if (it + NGW < items) TC_LOAD(vb, gb, it + NGW);
        TC_PROC(va, ga, it); it += NGW;
        if (it >= items) break;
        if (it + NGW < items) TC_LOAD(va, ga, it + NGW);
        TC_PROC(vb, gb, it); it += NGW;
    }
#undef TC_LOAD
#undef TC_PROC
}

__device__ __forceinline__ void unpack8(const v4u w, float (&f)[8]) {
    f[0] = bflo(w.x); f[1] = bfhi(w.x); f[2] = bflo(w.y); f[3] = bfhi(w.y); f[4] = bflo(w.z); f[5] = bfhi(w.z); f[6] = bflo(w.w); f[7] = bfhi(w.w);
}
__device__ __forceinline__ v4u pack8(const float (&f)[8]) { v4u w; w.x = pk2(f[0], f[1]); w.y = pk2(f[2], f[3]); w.z = pk2(f[4], f[5]); w.w = pk2(f[6], f[7]); return w; }

__device__ __forceinline__ void conv_fixup_phase(const gfloat* save, const gfloat* cw, gbf16* CVC, int gtid, int NT_) {
    constexpr int C4 = D / 4, NITEM = 64 * 2 * C4;
    for (int it = gtid; it < NITEM; it += NT_) {
        const int c4 = it % C4, pr = it / C4, r = pr & 1, p = pr >> 1;
        if ((p & 15) == 0) continue;
        const GAS f32x4* prev = (const GAS f32x4*)(save + ((size_t)(0 * 64 + p - 1) * 2) * D) + c4;
        const GAS f32x4* cs = (const GAS f32x4*)(save + ((size_t)(1 * 64 + p) * 2) * D) + c4;
        const f32x4 gm2 = r ? prev[C4] : prev[0], gm1 = r ? cs[0] : prev[C4], gc = r ? cs[C4] : cs[0];
        const f32x4 w0 = *((const GAS f32x4*)cw + c4), w1 = *((const GAS f32x4*)(cw + D) + c4), w2 = *((const GAS f32x4*)(cw + 2 * D) + c4);
        const f32x4 o = w0 * gm2 + w1 * gm1 + w2 * gc;
        v2u w; w.x = pk2(o[0], o[1]); w.y = pk2(o[2], o[3]);
        *((GAS v2u*)(CVC + (size_t)(p * 256 + r) * D) + c4) = w;
    }
}

__device__ __forceinline__ void ffn_fixup_phase(const gfloat* save, const gfloat* cw, const gfloat* cb, gbf16* ACT, int gtid, int NT_) {
    constexpr int C4 = DFF / 4, NITEM = 64 * 2 * C4;
    for (int it = gtid; it < NITEM; it += NT_) {
        const int c4 = it % C4, pr = it / C4, r = pr & 1, p = pr >> 1;
        if ((p & 15) == 0) continue;
        const GAS f32x4* prev = (const GAS f32x4*)(save + ((size_t)(0 * 64 + p - 1) * 2) * DFF) + c4;
        const GAS f32x4* gs = (const GAS f32x4*)(save + ((size_t)(1 * 64 + p) * 2) * DFF) + c4;
        const GAS f32x4* us = (const GAS f32x4*)(save + ((size_t)(2 * 64 + p) * 2) * DFF) + c4;
        const f32x4 gm2 = r ? prev[C4] : prev[0], gm1 = r ? gs[0] : prev[C4], gc = r ? gs[C4] : gs[0], uu = r ? us[C4] : us[0];
        const f32x4 w0 = *((const GAS f32x4*)cw + c4), w1 = *((const GAS f32x4*)(cw + DFF) + c4), w2 = *((const GAS f32x4*)(cw + 2 * DFF) + c4), bb = *((const GAS f32x4*)cb + c4);
        float o[4];
#pragma unroll
        for (int e = 0; e < 4; ++e) { const float cv = w0[e] * gm2[e] + w1[e] * gm1[e] + w2[e] * gc[e] + bb[e];
            o[e] = cv * __builtin_amdgcn_rcpf(1.0f + __builtin_amdgcn_exp2f(cv * -1.4426950408889634f)) * uu[e]; }
        v2u w; w.x = pk2(o[0], o[1]); w.y = pk2(o[2], o[3]);
        *((GAS v2u*)(ACT + (size_t)(p * 256 + r) * DFF) + c4) = w;
    }
}

namespace attn {
constexpr int KROW = 384, VROW = 128, KBUF = 64 * KROW, VBUF = 128 * VROW, NKS = 4, NVS = 3, LDS_V = NKS * KBUF, LDS_TOTAL = NKS * KBUF + NVS * VBUF;
constexpr int KPIECES = KBUF / 1024, VPIECES = VBUF / 1024;
static_assert(KPIECES == 24 && VPIECES == 16 && LDS_TOTAL <= RING_BYTES, "attention LDS");
constexpr float THR = 8.f;
struct Tensors { const gbf16* Q; const gbf16* KF; const gbf16* VT; gbf16* O; };
__device__ __forceinline__ float pair_max(float v) { auto rr = __builtin_amdgcn_permlane32_swap(__float_as_uint(v), __float_as_uint(v), false, false); return fmaxf(__uint_as_float(rr[0]), __uint_as_float(rr[1])); }
__device__ __forceinline__ float pair_sum(float v) { auto rr = __builtin_amdgcn_permlane32_swap(__float_as_uint(v), __float_as_uint(v), false, false); return __uint_as_float(rr[0]) + __uint_as_float(rr[1]); }
#define ATT_SB() __builtin_amdgcn_sched_barrier(0)

__device__ __forceinline__ void qk_tile(f32x16& p0, f32x16& p1, const LAS unsigned char* ks, const unsigned (&kx)[4], const bf16x8 (&qf)[12], float base) {
#pragma unroll
    for (int r = 0; r < 16; ++r) { p0[r] = -base; p1[r] = -base; }
    bf16x8 ka[2][2], kc[2][2];
#pragma unroll
    for (int s = 0; s < 2; ++s) { ka[0][s] = *(const LAS bf16x8*)(ks + kx[s]); kc[0][s] = *(const LAS bf16x8*)(ks + kx[s] + 32 * KROW); }
    ATT_SB();
#pragma unroll
    for (int g = 0; g < 6; ++g) {
        if (g < 5) {
#pragma unroll
            for (int s = 0; s < 2; ++s) { const int st = 2 * g + 2 + s;
                ka[(g + 1) & 1][s] = *(const LAS bf16x8*)(ks + kx[st & 3] + 128 * (st >> 2)); kc[(g + 1) & 1][s] = *(const LAS bf16x8*)(ks + kx[st & 3] + 128 * (st >> 2) + 32 * KROW); }
        }
#pragma unroll
        for (int s = 0; s < 2; ++s) { p0 = __builtin_amdgcn_mfma_f32_32x32x16_bf16(ka[g & 1][s], qf[2 * g + s], p0, 0, 0, 0); p1 = __builtin_amdgcn_mfma_f32_32x32x16_bf16(kc[g & 1][s], qf[2 * g + s], p1, 0, 0, 0); }
        ATT_SB();
    }
}
__device__ __forceinline__ void softmax_tile(f32x16& p0, f32x16& p1, f32x16 (&o)[4], float& m_run, float& l_run, bf16x8 (&pb)[2][2], float base) {
    float pm = p0[0];
#pragma unroll
    for (int r = 1; r < 16; ++r) pm = fmaxf(pm, p0[r]);
#pragma unroll
    for (int r = 0; r < 16; ++r) pm = fmaxf(pm, p1[r]);
    pm = pair_max(pm) + base;
    if (!__all(pm - m_run <= THR)) {
        const float m_new = fmaxf(m_run, pm), alpha = __builtin_amdgcn_exp2f(m_run - m_new), sh = m_new - base; m_run = m_new; l_run *= alpha;
#pragma unroll
        for (int d = 0; d < 4; ++d)
#pragma unroll
            for (int r = 0; r < 16; ++r) o[d][r] *= alpha;
#pragma unroll
        for (int r = 0; r < 16; ++r) { p0[r] -= sh; p1[r] -= sh; }
    }
    f32x2 ps = {0.f, 0.f};
#pragma unroll
    for (int r = 0; r < 16; r += 2) { p0[r] = __builtin_amdgcn_exp2f(p0[r]); p0[r + 1] = __builtin_amdgcn_exp2f(p0[r + 1]); ps += (f32x2){p0[r], p0[r + 1]}; }
#pragma unroll
    for (int r = 0; r < 16; r += 2) { p1[r] = __builtin_amdgcn_exp2f(p1[r]); p1[r + 1] = __builtin_amdgcn_exp2f(p1[r + 1]); ps += (f32x2){p1[r], p1[r + 1]}; }
    l_run += ps.x + ps.y;
#pragma unroll
    for (int s = 0; s < 2; ++s) {
        v4u w0, w1;
        w0.x = pk2(p0[8 * s + 0], p0[8 * s + 1]); w0.y = pk2(p0[8 * s + 2], p0[8 * s + 3]); w0.z = pk2(p0[8 * s + 4], p0[8 * s + 5]); w0.w = pk2(p0[8 * s + 6], p0[8 * s + 7]);
        w1.x = pk2(p1[8 * s + 0], p1[8 * s + 1]); w1.y = pk2(p1[8 * s + 2], p1[8 * s + 3]); w1.z = pk2(p1[8 * s + 4], p1[8 * s + 5]); w1.w = pk2(p1[8 * s + 6], p1[8 * s + 7]);
        pb[0][s] = __builtin_bit_cast(bf16x8, w0); pb[1][s] = __builtin_bit_cast(bf16x8, w1);
    }
}
__device__ __forceinline__ void pv_tile(f32x16 (&o)[4], const LAS unsigned char* vs, const unsigned (&vx)[4], const bf16x8 (&pb)[2][2]) {
    bf16x8 va[2][4];
#pragma unroll
    for (int i = 0; i < 4; ++i) va[0][i] = *(const LAS bf16x8*)(vs + vx[i]);
    ATT_SB();
#pragma unroll
    for (int db = 0; db < 4; ++db) {
        if (db < 3) {
#pragma unroll
            for (int i = 0; i < 4; ++i) va[(db + 1) & 1][i] = *(const LAS bf16x8*)(vs + vx[i] + (db + 1) * 32 * VROW);
        }
#pragma unroll
        for (int i = 0; i < 4; ++i) o[db] = __builtin_amdgcn_mfma_f32_32x32x16_bf16(va[db & 1][i], pb[i >> 1][i & 1], o[db], 0, 0, 0);
        ATT_SB();
    }
}

__device__ __forceinline__ void unit(LAS unsigned char* lds, const Tensors& X, int b, int h, int qb, int wid, int lane) {
    const int r32 = lane & 31, hi = lane >> 5, grp = 0;
    const size_t row_q = (size_t)b * SEQ + qb * 256 + wid * 32 + r32;
    bf16x8 qf[12];
    { const gbf16* qp = X.Q + row_q * (NH * QKD) + h * QKD + hi * 8;
#pragma unroll
      for (int s = 0; s < 12; ++s) qf[s] = *(const GAS bf16x8*)(qp + 16 * s); }
    const int ntile = 4 * qb + 4, my_last = 4 * qb + (wid >> 1);
    unsigned koff[3], voff[2];
#pragma unroll
    for (int i = 0; i < 3; ++i) { const int ch = 64 * (wid + 8 * i) + lane, row = ch / 24, cp = ch % 24, c = (cp & ~7) | ((cp ^ (row >> 1)) & 7); koff[i] = (unsigned)(row * (NH * QKD * 2) + c * 16); }
#pragma unroll
    for (int i = 0; i < 2; ++i) { const int ch = 64 * (wid + 8 * i) + lane, d = ch >> 3, cp = ch & 7, c = (cp ^ (d >> 1)) & 7; voff[i] = (unsigned)(d * (T * 2) + c * 16); }
    const GAS char* kbase = (const GAS char*)X.KF + ((size_t)b * SEQ * (NH * QKD) + h * QKD) * 2;
    const GAS char* vbase = (const GAS char*)X.VT + ((size_t)h * VD * T + (size_t)b * SEQ) * 2;
    const unsigned lds_u = (unsigned)(__UINTPTR_TYPE__)lds;
#define ATT_ISSUE_K(tile, slot) do { const GAS char* kb_ = kbase + (size_t)(tile) * (64 * NH * QKD * 2); _Pragma("unroll") for (int i_ = 0; i_ < 3; ++i_) \
        asm volatile("s_mov_b32 m0, %1\n\ts_nop 0\n\tglobal_load_lds_dwordx4 %0, %2" :: "v"(koff[i_]), "s"(lds_u + (unsigned)((slot) * KBUF + (wid + 8 * i_) * 1024)), "s"(kb_) : "memory"); } while (0)
#define ATT_ISSUE_V(tile, slot) do { const GAS char* vb_ = vbase + (size_t)(tile) * 128; _Pragma("unroll") for (int i_ = 0; i_ < 2; ++i_) \
        asm volatile("s_mov_b32 m0, %1\n\ts_nop 0\n\tglobal_load_lds_dwordx4 %0, %2" :: "v"(voff[i_]), "s"(lds_u + (unsigned)(LDS_V + (slot) * VBUF + (wid + 8 * i_) * 1024)), "s"(vb_) : "memory"); } while (0)
#define ATT_SYNC_ISSUE(j_) do { \
        if ((j_) + 2 < ntile) asm volatile("s_waitcnt vmcnt(5)" ::: "memory"); else if ((j_) + 1 < ntile) asm volatile("s_waitcnt vmcnt(2)" ::: "memory"); else asm volatile("s_waitcnt vmcnt(0)" ::: "memory"); \
        __builtin_amdgcn_s_barrier(); asm volatile("" ::: "memory"); \
        if ((j_) + 3 < ntile) ATT_ISSUE_K((j_) + 3, (sk + 3) & 3); if ((j_) + 2 < ntile) ATT_ISSUE_V((j_) + 2, sv2); } while (0)
    f32x16 o[4];
#pragma unroll
    for (int d = 0; d < 4; ++d)
#pragma unroll
        for (int r = 0; r < 16; ++r) o[d][r] = 0.f;
    float m_run = -1e30f, l_run = 0.f, base = 0.f;
    f32x16 p0, p1;
#pragma unroll
    for (int r = 0; r < 16; ++r) { p0[r] = 0.f; p1[r] = 0.f; }
    ATT_ISSUE_K(0, 0); ATT_ISSUE_V(0, 0); ATT_ISSUE_K(1, 1); ATT_ISSUE_K(2, 2); ATT_ISSUE_V(1, 1);
    asm volatile("s_waitcnt vmcnt(5)" ::: "memory"); __builtin_amdgcn_s_barrier(); asm volatile("" ::: "memory");
    const int pi = (r32 & ~0xC) | ((r32 & 4) << 1) | ((r32 & 8) >> 1), gk = (pi >> 1) & 7, gv = (r32 >> 1) & 7;
    unsigned kx[4], vx[4];
#pragma unroll
    for (int i = 0; i < 4; ++i) { kx[i] = (unsigned)(pi * KROW + (((2 * i + hi) ^ gk) & 7) * 16); vx[i] = (unsigned)(LDS_V + r32 * VROW + (((2 * i + hi) ^ gv) & 7) * 16); }
    int sk = 0, sv = 0;
    for (int j = 0; j <= ntile; ++j) {
        const int sv1 = (sv == 0) ? 2 : sv - 1, sv2 = (sv == 0) ? 2 : sv - 1;
        if (j >= 1 && j - 1 <= my_last) {
            bf16x8 pb[2][2];
            softmax_tile(p0, p1, o, m_run, l_run, pb, base);
            pv_tile(o, lds + sv1 * VBUF, vx, pb);
        }
        if (grp == 0) ATT_SYNC_ISSUE(j);
        if (j < ntile && j <= my_last) { base = (j == 0) ? 0.f : m_run; qk_tile(p0, p1, lds + sk * KBUF, kx, qf, base); }
        if (grp == 1) ATT_SYNC_ISSUE(j);
        sk = (sk + 1) & 3; sv = (sv == 2) ? 0 : sv + 1;
    }
#undef ATT_ISSUE_K
#undef ATT_ISSUE_V
#undef ATT_SYNC_ISSUE
    const float inv = 1.0f / pair_sum(l_run);
    gbf16* op = X.O + row_q * D + h * VD + 4 * hi;
#pragma unroll
    for (int db = 0; db < 4; ++db)
#pragma unroll
        for (int g = 0; g < 4; ++g) { v2u w; w.x = pk2(o[db][4 * g + 0] * inv, o[db][4 * g + 1] * inv); w.y = pk2(o[db][4 * g + 2] * inv, o[db][4 * g + 3] * inv);
            *(GAS v2u*)(op + 32 * db + 8 * g) = w; }
}
__device__ __forceinline__ void phase(LAS unsigned char* lds, const Tensors& X, int vcu, int G, int wid, int lane) {
    for (int p2 = 2 * vcu; p2 < BATCH * NH * 16; p2 += ((p2 & 1) ? 2 * G - 1 : 1)) {
        const int p = p2 >> 1, bh = p >> 3, qq = p & 7, b = bh / NH, h = bh % NH;
        unit(lds, X, b, h, (p2 & 1) ? qq : 15 - qq, wid, lane);
    }
}
}

__device__ const double INVF[32] = {1.0, 0.7498942093324559, 0.5623413251903491, 0.4216965034285822, 0.31622776601683794, 0.23713737056616552, 0.1778279410038923, 0.1333521432163324,
    0.1, 0.07498942093324558, 0.05623413251903491, 0.042169650342858224, 0.03162277660168379, 0.023713737056616554, 0.01778279410038923, 0.01333521432163324,
    0.01, 0.007498942093324558, 0.005623413251903491, 0.004216965034285823, 0.0031622776601683794, 0.0023713737056616554, 0.0017782794100389228, 0.001333521432163324,
    0.001, 0.0007498942093324559, 0.0005623413251903491, 0.00042169650342858224, 0.00031622776601683794, 0.00023713737056616554, 0.00017782794100389227, 0.0001333521432163324};
struct Args {
    const float* x; const int* pos; const float* attn_g; const float* ffn_g; const float* final_g;
    const float* sc_w_in; const float* sc_conv_w; const float* sc_w_out;
    const float* wq_a; const float* q_g; const float* wq_b; const float* wkv_a; const float* kv_g; const float* wkv_b; const float* wo;
    const float* w_gate; const float* w_up; const float* f_conv_w; const float* f_conv_b; const float* w_down;
    float* out; unsigned char* ws; int ph_lo, ph_hi;
};
constexpr int PH_PER_LAYER = 10, PH_FINAL = 1 + DEPTH * PH_PER_LAYER, PH_COUNT = PH_FINAL + 1;
template <class P, int OFF> __device__ __forceinline__ P karg_ptr() {
    unsigned long long v; auto kp = __builtin_amdgcn_kernarg_segment_ptr();
    asm volatile("s_load_dwordx2 %0, %1, %2\n\ts_waitcnt lgkmcnt(0)" : "=s"(v) : "s"(kp), "i"(OFF));
    return (P)v;
}
#define KARG(m) karg_ptr<GAS std::remove_pointer<decltype(Args::m)>::type*, offsetof(Args, m)>()
struct Idx { int tid, lane, wave, G, bx, vcu, gw, NGW, gtid, NTHR; };
__device__ __forceinline__ Idx make_idx() {
    Idx I; int t = threadIdx.x; asm volatile("" : "+v"(t));
    I.tid = t; I.lane = t & 63; I.wave = __builtin_amdgcn_readfirstlane(t >> 6); I.G = gridDim.x; I.bx = blockIdx.x;
    I.vcu = (I.G % 8 == 0) ? (I.bx % 8) * (I.G / 8) + I.bx / 8 : I.bx;
    I.gw = I.bx * NWAVES + I.wave; I.NGW = I.G * NWAVES; I.gtid = I.bx * (NWAVES * 64) + t; I.NTHR = I.G * NWAVES * 64; return I;
}

__global__ void __launch_bounds__(NWAVES * 64, 2) trunk_fwd(Args a) {
    extern __shared__ __attribute__((aligned(16))) unsigned char lds_raw[];
    LAS unsigned char* lds = (LAS unsigned char*)lds_raw;
    for (int u = threadIdx.x; u < (LDS_BYTES - LDSCTL_OFF) / 4; u += NWAVES * 64) ((LAS unsigned*)(lds + LDSCTL_OFF))[u] = 0u;
    __syncthreads();
    const int lo = a.ph_lo, hi = a.ph_hi;
    if (hi - lo > 1) (void)xcd_barrier_post((gu32*)(KARG(ws) + WS_CTL) + CW_BAR, (volatile LAS unsigned*)(lds + MISC_OFF) + 8);
#define IN(k) (lo <= (k) && (k) < hi)
#define SEAM(k) do { if ((k) + 1 < hi) { XcdBarrier bar_; bar_.bar = (gu32*)(KARG(ws) + WS_CTL) + CW_BAR; bar_.x = xb_xcc_id(); bar_.st = (volatile LAS unsigned*)(lds + MISC_OFF) + 8; xcd_barrier(bar_); } } while (0)
#define WSP(T_, off) ((GAS T_*)(KARG(ws) + (off)))

    if (IN(0)) {
        const Idx I = make_idx(); const int gw = I.gw, NGW = I.NGW, lane = I.lane;
        { gfloat* tab = WSP(float, WS_TAB); const gint* pos = KARG(pos);
          for (int i = I.gtid; i < T * 32; i += I.NTHR) { const int row = i >> 5, f = i & 31;
            const double rev = (double)pos[row] * INVF[f] * 0.15915494309189535;
            const float fr = (float)(rev - rint(rev));
            tab[2 * i] = __builtin_amdgcn_cosf(fr); tab[2 * i + 1] = __builtin_amdgcn_sinf(fr); } }
        LAS unsigned char* scr = lds + RING_OFF + I.wave * 8192;
        guchar* ws = KARG(ws);
        { const gfloat* x = KARG(x); gbf16* HB = (gbf16*)(ws + WS_XN); gu64* ssq0 = (gu64*)(ws + WS_SSQ);
          for (int row = gw; row < T; row += NGW) {
            const GAS f32x4* xr = (const GAS f32x4*)(x + (size_t)row * D) + lane; GAS v2u* o8 = (GAS v2u*)(HB + (size_t)row * D) + lane; float ss = 0.f;
#pragma unroll
            for (int jj = 0; jj < 16; ++jj) { const f32x4 v = xr[64 * jj]; ss += (v.x * v.x + v.y * v.y) + (v.z * v.z + v.w * v.w); v2u w; w.x = pk2(v.x, v.y); w.y = pk2(v.z, v.w); o8[64 * jj] = w; }
            ss = wave_sum(ss); if (lane == 0) ssq0[row] = pg8::ssq_fix(ss); } }
        const gfloat* attn_g = KARG(attn_g); const gfloat* ffn_g = KARG(ffn_g);
        transpose_cols(KARG(sc_w_in) + (size_t)1 * D * 3 * D + D, D, 3 * D, 2 * D, RowCvbOff{D}, attn_g + (size_t)2 * D, (gbf16*)(ws + WS_WIN + 1 * SZ_WIN), scr, gw, NGW, lane);
        for (int j = 0; j < 2; ++j) {
            if (j == 0) {
            transpose_cols(KARG(sc_w_in) + (size_t)j * D * 3 * D, D, 3 * D, 3 * D, RowCvb{}, attn_g + (size_t)(2 * j) * D, (gbf16*)(ws + WS_WIN + j * SZ_WIN), scr, gw, NGW, lane);
            transpose_cols(KARG(sc_w_out) + (size_t)j * D * D, D, D, D, RowPlain{0}, nullptr, (gbf16*)(ws + WS_WOUT + j * SZ_WOUT), scr, gw, NGW, lane);
            transpose_cols(KARG(wq_a) + (size_t)j * D * QLORA, D, QLORA, QLORA, RowPlain{0}, attn_g + (size_t)(2 * j + 1) * D, (gbf16*)(ws + WS_WQKVA + j * SZ_WQKVA), scr, gw, NGW, lane);
            transpose_cols(KARG(wkv_a) + (size_t)j * D * (KVLORA + ROPE), D, KVLORA + ROPE, KVLORA + ROPE, RowKva{}, attn_g + (size_t)(2 * j + 1) * D, (gbf16*)(ws + WS_WQKVA + j * SZ_WQKVA), scr, gw, NGW, lane);
            }
            { GAS v4u* z = (GAS v4u*)(ws + WS_WQKVA + j * SZ_WQKVA + (size_t)(QLORA + KVLORA + ROPE) * D * 2);
              for (int i = I.gtid; i < (NQKVA - QLORA - KVLORA - ROPE) * D * 2 / 16; i += I.NTHR) z[i] = (v4u){0u, 0u, 0u, 0u}; }
        }
        for (int i = 0; i < 1; ++i) {
            transpose_cols(KARG(w_gate) + (size_t)i * D * DFF, D, DFF, DFF, RowGu{0}, ffn_g + (size_t)i * D, (gbf16*)(ws + WS_WGU + i * SZ_WGU), scr, gw, NGW, lane);
            transpose_cols(KARG(w_up) + (size_t)i * D * DFF, D, DFF, DFF, RowGu{1}, ffn_g + (size_t)i * D, (gbf16*)(ws + WS_WGU + i * SZ_WGU), scr, gw, NGW, lane);
        }
        SEAM(0);
    }

    for (int L = 0; L < DEPTH; ++L) {
        const int pb = 1 + L * PH_PER_LAYER, j = L >> 1;
#define SSQ(i) ((gu64*)(KARG(ws) + WS_SSQ) + (size_t)(i) * T)
        if ((L & 1) == 0) {
            if (IN(pb + 1)) {
                pg8::Gemm g = pg8::make_gemm(WSP(bf16, WS_XN), WSP(bf16, WS_WIN + j * SZ_WIN), T, 2 * D, D, D, D); pg8::StaticOrder S; S.init(T, 2 * D, gridDim.x, blockIdx.x);
                pg8::EpiCv E{WSP(bf16, WS_CVC), SSQ(2 * L), WSP(float, WS_HALO), KARG(sc_conv_w) + (size_t)j * 3 * D, (LAS float*)(lds + XCH_OFF), D};
                pg8::gemm_phase<pg8::EpiCv, pg8::StaticOrder, true, true, pg8::Row4>(lds + RING_OFF, g, S, E);
                SEAM(pb + 1);
            }
            if (IN(pb + 2)) { const Idx I = make_idx(); conv_fixup_phase(WSP(float, WS_HALO), KARG(sc_conv_w) + (size_t)j * 3 * D, WSP(bf16, WS_CVC), I.gtid, I.NTHR); SEAM(pb + 2); }
            if (IN(pb + 3)) {
                pg8::Gemm g = pg8::make_gemm(WSP(bf16, WS_XN), WSP(bf16, WS_WIN + j * SZ_WIN) + (size_t)2 * D * D, T, D, D, D, D); pg8::StaticOrder S; S.init(T, D, gridDim.x, blockIdx.x);
                pg8::EpiY E{WSP(bf16, WS_Y), WSP(bf16, WS_CVC), SSQ(2 * L), D};
                pg8::gemm_phase<pg8::EpiY, pg8::StaticOrder, true, true>(lds + RING_OFF, g, S, E);
                SEAM(pb + 3);
            }
            if (IN(pb + 4)) {
                pg8::Gemm g = pg8::make_gemm(WSP(bf16, WS_Y), WSP(bf16, WS_WOUT + j * SZ_WOUT), T, D, D, D, D); pg8::StaticOrder S; S.init(T, D, gridDim.x, blockIdx.x);
                pg8::EpiResid E{WSP(bf16, WS_XN), SSQ(2 * L + 1), D};
                pg8::gemm_phase<pg8::EpiResid, pg8::StaticOrder, true, true>(lds + RING_OFF, g, S, E);
                SEAM(pb + 4);
            }
        } else {
            if (IN(pb + 1)) {
                pg8::Gemm g = pg8::make_gemm(WSP(bf16, WS_XN), WSP(bf16, WS_WQKVA + j * SZ_WQKVA), T, NQKVA, D, D, D); pg8::StaticOrder S; S.init(T, NQKVA, gridDim.x, blockIdx.x);
                pg8::EpiQkva E{WSP(bf16, WS_QA), WSP(bf16, WS_KR), WSP(float, WS_TAB), SSQ(2 * L), SSQ(SSQ_Q + 2 * j), SSQ(SSQ_KV + 2 * j)};
                pg8::gemm_phase<pg8::EpiQkva, pg8::StaticOrder, true, true>(lds + RING_OFF, g, S, E);
                {
                    constexpr int NU = (T / 256) * (NQKVA / 256);
                    const int G_ = gridDim.x, nfull = NU % G_, nconv = (nfull == 0) ? G_ : G_ - nfull, cw0 = (nfull == 0) ? 0 : nfull;
                    if ((int)blockIdx.x >= cw0) { const Idx I = make_idx(); guchar* ws = KARG(ws); LAS unsigned char* scr = lds + RING_OFF + I.wave * 8192;
                        const int gw = ((int)blockIdx.x - cw0) * NWAVES + I.wave, NGW = nconv * NWAVES, lane = I.lane;
                        transpose_cols_pipe(KARG(wq_b) + (size_t)j * QLORA * NH * QKD, QLORA, NH * QKD, NH * QKD, RowQb{}, KARG(q_g) + (size_t)j * QLORA, (gbf16*)(ws + WS_WQB + j * SZ_WQB), scr, gw, NGW, lane);
                        transpose_cols_pipe(KARG(wkv_b) + (size_t)j * KVLORA * NH * (NOPE + VD), KVLORA, NH * (NOPE + VD), NH * (NOPE + VD), RowKvb{}, KARG(kv_g) + (size_t)j * KVLORA, (gbf16*)(ws + WS_WUK + j * SZ_WKVB), scr, gw, NGW, lane);
                        transpose_cols_pipe(KARG(wo) + (size_t)j * D * D, D, D, D, RowPlain{0}, nullptr, (gbf16*)(ws + WS_WO + j * SZ_WO), scr, gw, NGW, lane);
                    }
                }
                SEAM(pb + 1);
            }
            if (IN(pb + 3)) {
                { pg8::Gemm g = pg8::make_gemm(WSP(bf16, WS_QA), WSP(bf16, WS_WQB + j * SZ_WQB), T, NH * QKD, QLORA, QLORA + KVLORA, QLORA); pg8::StaticOrder S; S.init(T, NH * QKD, gridDim.x, blockIdx.x);
                  pg8::EpiQ E{WSP(bf16, WS_Q), NH * QKD, WSP(float, WS_TAB), QSCALE, SSQ(SSQ_Q + 2 * j), 1.0f / QLORA};
                  pg8::gemm_phase<pg8::EpiQ, pg8::StaticOrder, true, true>(lds + RING_OFF, g, S, E); }
                { pg8::Gemm g = pg8::make_gemm(WSP(bf16, WS_QA) + QLORA, WSP(bf16, WS_WUK + j * SZ_WKVB), T, NH * NOPE, KVLORA, QLORA + KVLORA, KVLORA); pg8::StaticOrder S; S.init(T, NH * NOPE, gridDim.x, blockIdx.x);
                  pg8::EpiKN E{WSP(bf16, WS_KF), WSP(bf16, WS_KR), SSQ(SSQ_KV + 2 * j), 1.0f / KVLORA};
                  pg8::gemm_phase<pg8::EpiKN, pg8::StaticOrder, true, true>(lds + RING_OFF, g, S, E); }
                { pg8::Gemm g = pg8::make_gemm(WSP(bf16, WS_WUV + j * SZ_WKVB), WSP(bf16, WS_QA) + QLORA, NH * VD, T, KVLORA, KVLORA, QLORA + KVLORA); pg8::StaticOrder S; S.init(NH * VD, T, gridDim.x, blockIdx.x);
                  pg8::EpiVT E{WSP(bf16, WS_VT), T, SSQ(SSQ_KV + 2 * j), 1.0f / KVLORA};
                  pg8::gemm_phase<pg8::EpiVT, pg8::StaticOrder, true, true>(lds + RING_OFF, g, S, E); }
                SEAM(pb + 3);
            }
            if (IN(pb + 4)) {
                const Idx I = make_idx();
                const attn::Tensors X{WSP(bf16, WS_Q), WSP(bf16, WS_KF), WSP(bf16, WS_VT), WSP(bf16, WS_O)};
                attn::phase(lds + RING_OFF, X, I.vcu, I.G, I.wave, I.lane);
                SEAM(pb + 4);
            }
            if (IN(pb + 5)) {
                pg8::Gemm g = pg8::make_gemm(WSP(bf16, WS_O), WSP(bf16, WS_WO + j * SZ_WO), T, D, D, D, D); pg8::StaticOrder S; S.init(T, D, gridDim.x, blockIdx.x);
                pg8::EpiResid E{WSP(bf16, WS_XN), SSQ(2 * L + 1), D};
                pg8::gemm_phase<pg8::EpiResid, pg8::StaticOrder, true, true>(lds + RING_OFF, g, S, E);
                SEAM(pb + 5);
            }
        }
        if (IN(pb + 7)) {
            pg8::Gemm g = pg8::make_gemm(WSP(bf16, WS_XN), WSP(bf16, WS_WGU + L * SZ_WGU), T, 2 * DFF, D, D, D); pg8::StaticOrder S; S.init(T, 2 * DFF, gridDim.x, blockIdx.x);
            const bool cvn = (L + 1 < DEPTH);
            pg8::EpiFfn E{WSP(bf16, WS_ACT), SSQ(2 * L + 1), WSP(float, WS_HALO), KARG(f_conv_w) + (size_t)L * 3 * DFF, KARG(f_conv_b) + (size_t)L * DFF, (LAS float*)(lds + XCH_OFF), DFF,
                          cvn ? KARG(w_gate) + (size_t)(L + 1) * D * DFF : nullptr, cvn ? KARG(w_up) + (size_t)(L + 1) * D * DFF : nullptr, KARG(ffn_g) + (size_t)(cvn ? L + 1 : 0) * D,
                          WSP(bf16, WS_WGU + (size_t)(cvn ? L + 1 : 0) * SZ_WGU), lds + RING_OFF + 8 * pg8::HTB};
            pg8::gemm_phase<pg8::EpiFfn, pg8::StaticOrder, true, true, pg8::Row4>(lds + RING_OFF, g, S, E);
            {
                constexpr int NMAIN = (T / 256) * (2 * DFF / 256);
                const int G_ = gridDim.x, nfull = NMAIN % G_, nconv = (nfull == 0) ? G_ : G_ - nfull, cw0 = (nfull == 0) ? 0 : nfull;
                if ((int)blockIdx.x >= cw0) { const Idx I = make_idx(); LAS unsigned char* scr = lds + RING_OFF + I.wave * 8192; const int gwt = ((int)blockIdx.x - cw0) * NWAVES + I.wave, ngwt = nconv * NWAVES;
                    transpose_cols_pipe(KARG(w_down) + (size_t)L * DFF * D, DFF, D, D, RowPlain{0}, nullptr, WSP(bf16, WS_WDN + L * SZ_WDN), scr, gwt, ngwt, I.lane);
                    if (L == 0) { const gfloat* ag = KARG(attn_g); guchar* ws = KARG(ws);
                        transpose_cols_pipe(KARG(sc_w_out) + (size_t)1 * D * D, D, D, D, RowPlain{0}, nullptr, (gbf16*)(ws + WS_WOUT + 1 * SZ_WOUT), scr, gwt, ngwt, I.lane);
                        transpose_cols_pipe(KARG(wq_a) + (size_t)1 * D * QLORA, D, QLORA, QLORA, RowPlain{0}, ag + (size_t)3 * D, (gbf16*)(ws + WS_WQKVA + 1 * SZ_WQKVA), scr, gwt, ngwt, I.lane);
                        transpose_cols_pipe(KARG(wkv_a) + (size_t)1 * D * (KVLORA + ROPE), D, KVLORA + ROPE, KVLORA + ROPE, RowKva{}, ag + (size_t)3 * D, (gbf16*)(ws + WS_WQKVA + 1 * SZ_WQKVA), scr, gwt, ngwt, I.lane); }
                    if (L == 1) { const gfloat* ag = KARG(attn_g); guchar* ws = KARG(ws);
                        transpose_cols_pipe(KARG(sc_w_in) + (size_t)1 * D * 3 * D, D, 3 * D, D, RowCvb{}, ag + (size_t)2 * D, (gbf16*)(ws + WS_WIN + 1 * SZ_WIN), scr, gwt, ngwt, I.lane); }
                }
            }
            SEAM(pb + 7);
        }
        if (IN(pb + 8)) { const Idx I = make_idx(); ffn_fixup_phase(WSP(float, WS_HALO), KARG(f_conv_w) + (size_t)L * 3 * DFF, KARG(f_conv_b) + (size_t)L * DFF, WSP(bf16, WS_ACT), I.gtid, I.NTHR); SEAM(pb + 8); }
        if (IN(pb + 9)) {
            pg8::Gemm g = pg8::make_gemm(WSP(bf16, WS_ACT), WSP(bf16, WS_WDN + L * SZ_WDN), T, D, DFF, DFF, DFF); pg8::StaticOrder S; S.init(T, D, gridDim.x, blockIdx.x, 4);
            pg8::EpiResid E{WSP(bf16, WS_XN), SSQ(2 * L + 2), D};
            pg8::gemm_phase<pg8::EpiResid, pg8::StaticOrder, true, true>(lds + RING_OFF, g, S, E);
            SEAM(pb + 9);
        }
    }
    if (IN(PH_FINAL)) { const Idx I = make_idx(); gfloat* o = KARG(out); const gfloat* g = KARG(final_g); const gu64* sq = SSQ(8); const gbf16* hb = WSP(bf16, WS_XN);
        for (int i = I.gtid; i < T * (D / 8); i += I.NTHR) { const int row = i >> 9, c8 = i & 511;
            const float s = pg8::rstd_of(sq, row, 1.0f / D); const f32x4 g0 = *((const GAS f32x4*)g + 2 * c8), g1 = *((const GAS f32x4*)g + 2 * c8 + 1);
            float f[8]; unpack8(*((const GAS v4u*)hb + i), f);
            GAS f32x4* p = (GAS f32x4*)o + 2 * (size_t)i;
            p[0] = (f32x4){f[0], f[1], f[2], f[3]} * s * g0; p[1] = (f32x4){f[4], f[5], f[6], f[7]} * s * g1; } }
#undef IN
#undef SEAM
#undef WSP
#undef SSQ
}

static bool phase_exists(int p) {
    if (p == 0 || p == PH_FINAL) return true;
    const int L = (p - 1) / PH_PER_LAYER, s = (p - 1) % PH_PER_LAYER;
    if (s >= 7) return true;
    return (L & 1) ? (s == 1 || s == 3 || s == 4 || s == 5) : (s == 1 || s == 2 || s == 3 || s == 4);
}
extern "C" void kernel_launch(void* const* d_in, const int* in_sizes, int n_in, void* d_out, int out_size, void* d_ws, size_t ws_size, hipStream_t stream) {
    static int grid = 0;
    if (grid == 0) {
        if (n_in != 20 || in_sizes[0] != T * D || out_size != T * D || ws_size < WS_END) {
            fprintf(stderr, "kernel_launch: unexpected shapes (n_in %d, in0 %d, out %d, ws %zu, need %zu); nothing launched\n", n_in, n_in > 0 ? in_sizes[0] : -1, out_size, ws_size, (size_t)WS_END); grid = -1; return; }
        int dev = 0, cus = 0, per_cu = 0;
        if (hipGetDevice(&dev) != hipSuccess || hipDeviceGetAttribute(&cus, hipDeviceAttributeMultiprocessorCount, dev) != hipSuccess) { grid = -1; return; }
        if (hipFuncSetAttribute((const void*)trunk_fwd, hipFuncAttributeMaxDynamicSharedMemorySize, LDS_BYTES) != hipSuccess) { fprintf(stderr, "kernel_launch: hipFuncSetAttribute failed\n"); grid = -1; return; }
        if (hipOccupancyMaxActiveBlocksPerMultiprocessor(&per_cu, (const void*)trunk_fwd, NWAVES * 64, LDS_BYTES) != hipSuccess || per_cu < 1)
            fprintf(stderr, "kernel_launch: note: occupancy query reports %d workgroups per CU\n", per_cu);
        (void)hipGetLastError();
        grid = cus;
    }
    if (grid < 0) return;
    if (hipMemsetAsync((char*)d_ws + WS_CTL, 0, CTL_ZERO_BYTES, stream) != hipSuccess) { fprintf(stderr, "kernel_launch: memset failed\n"); return; }
    Args a{};
    a.x = (const float*)d_in[0]; a.pos = (const int*)d_in[1]; a.attn_g = (const float*)d_in[2]; a.ffn_g = (const float*)d_in[3]; a.final_g = (const float*)d_in[4];
    a.sc_w_in = (const float*)d_in[5]; a.sc_conv_w = (const float*)d_in[6]; a.sc_w_out = (const float*)d_in[7];
    a.wq_a = (const float*)d_in[8]; a.q_g = (const float*)d_in[9]; a.wq_b = (const float*)d_in[10]; a.wkv_a = (const float*)d_in[11]; a.kv_g = (const float*)d_in[12];
    a.wkv_b = (const float*)d_in[13]; a.wo = (const float*)d_in[14];
    a.w_gate = (const float*)d_in[15]; a.w_up = (const float*)d_in[16]; a.f_conv_w = (const float*)d_in[17]; a.f_conv_b = (const float*)d_in[18]; a.w_down = (const float*)d_in[19];
    a.out = (float*)d_out; a.ws = (unsigned char*)d_ws;
#if MK_PER_PHASE
    for (int p = 0; p < PH_COUNT; ++p) {
        if (!phase_exists(p)) continue;
        a.ph_lo = p; a.ph_hi = p + 1;
        hipLaunchKernelGGL(trunk_fwd, dim3(grid), dim3(NWAVES * 64), LDS_BYTES, stream, a);
    }
#else
    a.ph_lo = 0; a.ph_hi = PH_COUNT;
    hipLaunchKernelGGL(trunk_fwd, dim3(grid), dim3(NWAVES * 64), LDS_BYTES, stream, a);
#endif
    const hipError_t le = hipPeekAtLastError();
    if (le != hipSuccess) fprintf(stderr, "kernel_launch: launch failed: %s\n", hipGetErrorName(le));
}
```
